# Optimizing an MI355X kernel written in HIP

```python
import math
import jax, jax.numpy as jnp
from jax import lax
import numpy as np

D_MODEL = 1024
BATCH = 4
SEQ = 4096
DEPTH = 2

D_MIX = D_MODEL
HEAD_DIM = 64
RET_HEADS = 4
RET_WIDTH = RET_HEADS * HEAD_DIM
RET_CHUNK = 128
ROPE_BASE = 10000.0
NSA_HEADS = 8
NSA_KV_HEADS = 2
NSA_GROUP = NSA_HEADS // NSA_KV_HEADS
NSA_WIDTH = NSA_HEADS * HEAD_DIM
NSA_KV_WIDTH = NSA_KV_HEADS * HEAD_DIM
CMP_LEN = 32
CMP_STRIDE = 16
SEL_LEN = 64
N_SELECT = 16
WINDOW = 512
NSA_QBLOCK = 64
N_BRANCH = 3
FORCE_SCORE = 1.0e4
LRU_WIDTH = D_MIX - RET_WIDTH - NSA_WIDTH
LRU_BLOCKS = 4
LRU_BLOCK_DIM = LRU_WIDTH // LRU_BLOCKS
CONV_WIDTH = 4
LRU_C = 8.0
DEEPNORM_ALPHA = (2.0 * DEPTH) ** 0.25
DEEPNORM_BETA = (8.0 * DEPTH) ** -0.25
LN_EPS = 1e-5

IN_SIZES = (RET_WIDTH,) * 4 + (NSA_WIDTH,) + (NSA_KV_WIDTH,) * 6 + (NSA_WIDTH, NSA_HEADS * N_BRANCH, LRU_WIDTH, LRU_WIDTH)
D_IN = sum(IN_SIZES)
IN_SPLIT_POINTS = tuple(int(v) for v in np.cumsum(IN_SIZES)[:-1])

kernel_name = "hybrid_retention_nsa_rglru_deepnorm"


def _normalize(x):
    xf = x.astype(jnp.float32)
    mu = jnp.mean(xf, axis=-1, keepdims=True)
    var = jnp.mean(jnp.square(xf - mu), axis=-1, keepdims=True)
    return (xf - mu) * lax.rsqrt(var + LN_EPS)


def layer_norm(x, g, b):
    return (_normalize(x) * g.astype(jnp.float32) + b.astype(jnp.float32)).astype(x.dtype)


def rotary(x, pos):
    half = x.shape[-1] // 2
    inv = 1.0 / (ROPE_BASE ** (jnp.arange(half, dtype=jnp.float32) / half))
    ang = pos.astype(jnp.float32)[:, None] * inv[None, :]
    cos, sin = jnp.cos(ang), jnp.sin(ang)
    x1, x2 = x[..., :half], x[..., half:]
    return jnp.concatenate([x1 * cos - x2 * sin, x1 * sin + x2 * cos], axis=-1).astype(x.dtype)


def masked_softmax(s, mask):
    logits = jnp.where(mask, s.astype(jnp.float32), -1e30)
    return jax.nn.softmax(logits, axis=-1)


def retention(q, k, v):
    B, S, _ = q.shape
    dt = q.dtype
    H, d, C = RET_HEADS, HEAD_DIM, RET_CHUNK
    nc = S // C

    def heads(t):
        return t.reshape(B, S, H, d).transpose(0, 2, 1, 3)

    pos = jnp.arange(S)
    qh = rotary(heads(q), pos)
    kh = rotary(heads(k), pos) * (d ** -0.5)
    vh = heads(v)
    log_g = jnp.log(1.0 - 2.0 ** (-5.0 - jnp.arange(H, dtype=jnp.float32)))
    idx = jnp.arange(C, dtype=jnp.float32)
    diff = idx[:, None] - idx[None, :]
    inner_decay = jnp.where(diff >= 0, jnp.exp(jnp.maximum(diff, 0.0)[None] * log_g[:, None, None]), 0.0).astype(dt)
    key_decay = jnp.exp((C - 1.0 - idx)[None, :] * log_g[:, None]).astype(dt)
    query_decay = jnp.exp((idx + 1.0)[None, :] * log_g[:, None]).astype(dt)
    chunk_decay = jnp.exp(C * log_g).astype(dt)

    qc = qh.reshape(B, H, nc, C, d)
    kc = kh.reshape(B, H, nc, C, d)
    vc = vh.reshape(B, H, nc, C, d)
    scores = jnp.einsum('bhnid,bhnjd->bhnij', qc, kc) * inner_decay[None, :, None]
    inner = jnp.einsum('bhnij,bhnjd->bhnid', scores, vc)
    kv = jnp.einsum('bhnjd,bhnje->nbhde', kc * key_decay[None, :, None, :, None], vc)

    def step(state, kv_c):
        return state * chunk_decay[None, :, None, None] + kv_c, state

    _, states = lax.scan(step, jnp.zeros((B, H, d, d), dt), kv)
    cross = jnp.einsum('bhnid,nbhde->bhnie', qc, states) * query_decay[None, :, None, :, None]
    y = (inner + cross).reshape(B, H, S, d)
    y = _normalize(y).astype(dt)
    return y.transpose(0, 2, 1, 3).reshape(B, S, RET_WIDTH)


def nsa(xq, k_c, v_c, k_s, v_s, k_w, v_w, gate_logits, cmp_pos, cmp_w):
    B, S, _ = xq.shape
    dt = xq.dtype
    G, R, dh, QB = NSA_KV_HEADS, NSA_GROUP, HEAD_DIM, NSA_QBLOCK
    q = xq.reshape(B, S, G, R, dh).transpose(0, 2, 3, 1, 4) * (dh ** -0.5)

    def kvh(t):
        return t.reshape(B, S, G, dh).transpose(0, 2, 1, 3)

    n_cmp = (S - CMP_LEN) // CMP_STRIDE + 1
    tok = np.arange(n_cmp)[:, None] * CMP_STRIDE + np.arange(CMP_LEN)[None, :]

    def compress(t, pos, w):
        blocks = t[:, :, tok] + pos
        return blocks.reshape(B, G, n_cmp, CMP_LEN * dh) @ w

    kc = compress(kvh(k_c), cmp_pos[0], cmp_w[0])
    vc = compress(kvh(v_c), cmp_pos[1], cmp_w[1])
    cmp_end = np.arange(n_cmp) * CMP_STRIDE + CMP_LEN - 1

    n_sel = S // SEL_LEN
    ci = np.arange(n_cmp)[:, None]
    sj = np.arange(n_sel)[None, :]
    overlap = np.minimum(ci * CMP_STRIDE + CMP_LEN, sj * SEL_LEN + SEL_LEN) - np.maximum(ci * CMP_STRIDE, sj * SEL_LEN)
    sel_map = jnp.asarray(np.clip(overlap, 0, None) / CMP_STRIDE, dtype=jnp.float32)
    top = min(N_SELECT, n_sel)
    ks_blocks = kvh(k_s).reshape(B, G, n_sel, SEL_LEN, dh)
    vs_blocks = kvh(v_s).reshape(B, G, n_sel, SEL_LEN, dh)
    gather = jax.vmap(jax.vmap(lambda blk, ix: blk[ix]))

    pad = ((0, 0), (0, 0), (WINDOW, 0), (0, 0))
    kw = jnp.pad(kvh(k_w), pad)
    vw = jnp.pad(kvh(v_w), pad)

    gates = jax.nn.sigmoid(gate_logits.astype(jnp.float32)).astype(dt)
    gates = gates.reshape(B, S, G, R, N_BRANCH).transpose(0, 2, 3, 1, 4)

    def block(i):
        start = i * QB
        t = start + jnp.arange(QB)
        qb = lax.dynamic_slice_in_dim(q, start, QB, axis=3)
        gb = lax.dynamic_slice_in_dim(gates, start, QB, axis=3)
        m_c = cmp_end[None, :] <= t[:, None]
        p_c = masked_softmax(jnp.einsum('bgrqd,bgnd->bgrqn', qb, kc), m_c)
        p_c = p_c * jnp.any(m_c, axis=-1)[:, None]
        o_c = jnp.einsum('bgrqn,bgnd->bgrqd', p_c.astype(dt), vc)
        imp = jnp.einsum('bgrqn,nj->bgqj', p_c, sel_map)
        j = jnp.arange(n_sel)[None, :]
        cur = (t // SEL_LEN)[:, None]
        forced = (j == 0) | (j == cur) | (j == cur - 1)
        causal = j * SEL_LEN <= t[:, None]
        imp = jnp.where(forced, FORCE_SCORE, jnp.where(causal, imp, -FORCE_SCORE))
        _, idx = lax.top_k(imp, top)
        k_sel = gather(ks_blocks, idx).reshape(B, G, QB, top * SEL_LEN, dh)
        v_sel = gather(vs_blocks, idx).reshape(B, G, QB, top * SEL_LEN, dh)
        kpos = (idx[..., None] * SEL_LEN + jnp.arange(SEL_LEN)).reshape(B, G, QB, top * SEL_LEN)
        m_s = (kpos <= t[:, None])[:, :, None]
        p_s = masked_softmax(jnp.einsum('bgrqd,bgqkd->bgrqk', qb, k_sel), m_s)
        o_s = jnp.einsum('bgrqk,bgqkd->bgrqd', p_s.astype(dt), v_sel)
        kwb = lax.dynamic_slice_in_dim(kw, start, WINDOW + QB, axis=2)
        vwb = lax.dynamic_slice_in_dim(vw, start, WINDOW + QB, axis=2)
        jpos = start - WINDOW + jnp.arange(WINDOW + QB)
        m_w = (jpos[None, :] >= 0) & (jpos[None, :] <= t[:, None]) & (jpos[None, :] > t[:, None] - WINDOW)
        p_w = masked_softmax(jnp.einsum('bgrqd,bgkd->bgrqk', qb, kwb), m_w)
        o_w = jnp.einsum('bgrqk,bgkd->bgrqd', p_w.astype(dt), vwb)
        return gb[..., 0:1] * o_c + gb[..., 1:2] * o_s + gb[..., 2:3] * o_w

    out = lax.map(block, jnp.arange(S // QB))
    return out.transpose(1, 0, 4, 2, 3, 5).reshape(B, S, NSA_WIDTH)


def rg_lru(x, conv_w, conv_b, w_a, b_a, w_x, b_x, lam):
    B, S, C = x.shape
    xc = lax.conv_general_dilated(x, conv_w[:, None, :], window_strides=(1,),
                                  padding=((CONV_WIDTH - 1, 0),),
                                  dimension_numbers=('NWC', 'WIO', 'NWC'),
                                  feature_group_count=C) + conv_b
    xb = xc.reshape(B, S, LRU_BLOCKS, LRU_BLOCK_DIM)
    r = jax.nn.sigmoid((jnp.einsum('bsnd,nde->bsne', xb, w_a).reshape(B, S, C) + b_a).astype(jnp.float32))
    i = jax.nn.sigmoid((jnp.einsum('bsnd,nde->bsne', xb, w_x).reshape(B, S, C) + b_x).astype(jnp.float32))
    log_a = -LRU_C * r * jax.nn.softplus(-lam.astype(jnp.float32))
    a = jnp.exp(log_a)
    u = jnp.sqrt(-jnp.expm1(2.0 * log_a)) * (i * xc.astype(jnp.float32))

    def combine(lhs, rhs):
        a1, b1 = lhs
        a2, b2 = rhs
        return a1 * a2, a2 * b1 + b2

    _, h = lax.associative_scan(combine, (a, u), axis=1)
    return h.astype(x.dtype)


def hybrid_layer(x, w_in, w_out, ln_g, ln_b, cmp_pos, cmp_w, conv_w, conv_b, w_a, b_a, w_x, b_x, lam):
    proj = x @ w_in
    (rq, rk, rv, rg, nq, nkc, nvc, nks, nvs, nkw, nvw, ng, ngl, lx, lg) = jnp.split(proj, IN_SPLIT_POINTS, axis=-1)
    y_ret = retention(rq, rk, rv) * jax.nn.silu(rg)
    y_nsa = nsa(nq, nkc, nvc, nks, nvs, nkw, nvw, ngl, cmp_pos, cmp_w) * jax.nn.silu(ng)
    y_lru = rg_lru(lx, conv_w, conv_b, w_a, b_a, w_x, b_x, lam) * jax.nn.silu(lg)
    y = jnp.concatenate([y_ret, y_nsa, y_lru], axis=-1) @ w_out
    return layer_norm(DEEPNORM_ALPHA * x + y, ln_g, ln_b)


def setup_inputs(seed: int = 0) -> dict:
    key = jax.random.key(seed)
    ks = jax.random.split(key, 16)
    f32 = jnp.float32
    x = jax.random.normal(ks[0], (BATCH, SEQ, D_MODEL), f32)
    w_in = jax.random.normal(ks[1], (DEPTH, D_MODEL, D_IN), f32) * D_MODEL ** -0.5
    w_out = jax.random.normal(ks[2], (DEPTH, D_MIX, D_MODEL), f32) * (D_MIX ** -0.5) * DEEPNORM_BETA
    ln_g = 1.0 + 0.02 * jax.random.normal(ks[3], (DEPTH, D_MODEL), f32)
    ln_b = 0.02 * jax.random.normal(ks[4], (DEPTH, D_MODEL), f32)
    nsa_cmp_pos = 0.1 * jax.random.normal(ks[5], (DEPTH, 2, CMP_LEN, HEAD_DIM), f32)
    nsa_cmp_w = jax.random.normal(ks[6], (DEPTH, 2, CMP_LEN * HEAD_DIM, HEAD_DIM), f32) * (CMP_LEN * HEAD_DIM) ** -0.5
    lru_conv_w = jax.random.normal(ks[7], (DEPTH, CONV_WIDTH, LRU_WIDTH), f32) * CONV_WIDTH ** -0.5
    lru_conv_b = 0.02 * jax.random.normal(ks[8], (DEPTH, LRU_WIDTH), f32)
    lru_w_a = jax.random.normal(ks[9], (DEPTH, LRU_BLOCKS, LRU_BLOCK_DIM, LRU_BLOCK_DIM), f32) * LRU_BLOCK_DIM ** -0.5
    lru_b_a = 0.02 * jax.random.normal(ks[10], (DEPTH, LRU_WIDTH), f32)
    lru_w_x = jax.random.normal(ks[11], (DEPTH, LRU_BLOCKS, LRU_BLOCK_DIM, LRU_BLOCK_DIM), f32) * LRU_BLOCK_DIM ** -0.5
    lru_b_x = 0.02 * jax.random.normal(ks[12], (DEPTH, LRU_WIDTH), f32)
    u = jax.random.uniform(ks[13], (DEPTH, LRU_WIDTH), f32, minval=0.9, maxval=0.999)
    a0 = u ** (1.0 / LRU_C)
    lru_lambda = jnp.log(a0) - jnp.log1p(-a0)
    return {"x": x, "w_in": w_in, "w_out": w_out, "ln_g": ln_g, "ln_b": ln_b,
            "nsa_cmp_pos": nsa_cmp_pos, "nsa_cmp_w": nsa_cmp_w,
            "lru_conv_w": lru_conv_w, "lru_conv_b": lru_conv_b,
            "lru_w_a": lru_w_a, "lru_b_a": lru_b_a, "lru_w_x": lru_w_x, "lru_b_x": lru_b_x,
            "lru_lambda": lru_lambda}


def reference(x, w_in, w_out, ln_g, ln_b, nsa_cmp_pos, nsa_cmp_w, lru_conv_w, lru_conv_b,
              lru_w_a, lru_b_a, lru_w_x, lru_b_x, lru_lambda):
    for l in range(DEPTH):
        x = hybrid_layer(x, w_in[l], w_out[l], ln_g[l], ln_b[l], nsa_cmp_pos[l], nsa_cmp_w[l],
                         lru_conv_w[l], lru_conv_b[l], lru_w_a[l], lru_b_a[l], lru_w_x[l], lru_b_x[l],
                         lru_lambda[l])
    return x
```

```cpp
#include <hip/hip_runtime.h>
#include <hip/hip_cooperative_groups.h>
#include <stdint.h>
#include <cstdio>
namespace cg = cooperative_groups;

typedef unsigned short bf16;
typedef __attribute__((ext_vector_type(8))) short bf16x8;
typedef __attribute__((ext_vector_type(4))) short s16x4;
typedef __attribute__((ext_vector_type(16))) float f32x16;
typedef __bf16 bf2_t __attribute__((ext_vector_type(2)));
typedef float fl2_t __attribute__((ext_vector_type(2)));
#define DI __device__ __forceinline__
#define MFMA32(a, b, c) __builtin_amdgcn_mfma_f32_32x32x16_bf16((a), (b), (c), 0, 0, 0)

#ifndef USE_CG
#define USE_CG 0
#endif
#ifndef COOP
#define COOP 1
#endif

constexpr int kT = 16384, kS = 4096, kDM = 1024, kNP = 3456, kDIN = 3352;
constexpr int LDK = 72;
constexpr int LDV = 136;
constexpr int LDS_BYTES = 108 * 1024;
constexpr int NPHASE = 11;

constexpr int C_RQ = 0, C_RK = 256, C_RV = 512, C_RG = 768, C_NQ = 1024, C_NKC = 1536, C_NVC = 1664, C_NKS = 1792,
              C_NVS = 1920, C_NKW = 2048, C_NVW = 2176, C_NG = 2304, C_NGL = 2816, C_LX = 2840, C_LG = 3096;

struct Params {
  const float *x, *w_in, *w_out, *ln_g, *ln_b, *cmp_pos, *cmp_w, *conv_w, *conv_b, *w_a, *b_a, *w_x, *b_x, *lam;
  float* out;
  bf16 *xb, *wint, *woutt, *cmpwt, *proj, *kdt, *vrt, *vst, *vwt, *kc, *vct, *wat, *wxt;
  float *cmpbp, *rot, *kvc, *cuma, *hloc, *suma, *sumh;
  unsigned* bar;
};

DI unsigned pack2(float a, float b) { fl2_t f = {a, b}; bf2_t r = __builtin_convertvector(f, bf2_t); return __builtin_bit_cast(unsigned, r); }
DI bf16 f2bf(float a) { return (bf16)(pack2(a, 0.f) & 0xffffu); }
DI float bf2f(bf16 b) { return __uint_as_float(((unsigned)b) << 16); }
DI int crow(int i, int hh) { return (i & 3) + 8 * (i >> 2) + 4 * hh; }
DI float sigmoidf_(float x) { return 1.f / (1.f + __expf(-x)); }
DI float siluf_(float x) { return x / (1.f + __expf(-x)); }
DI float xor32x(float v, int hh) {
  auto r = __builtin_amdgcn_permlane32_swap(__float_as_uint(v), __float_as_uint(v), false, false);
  return __uint_as_float(hh ? r[0] : r[1]);
}
DI float rmax32(float v) { auto r = __builtin_amdgcn_permlane32_swap(__float_as_uint(v), __float_as_uint(v), false, false); return fmaxf(__uint_as_float(r[0]), __uint_as_float(r[1])); }
DI float rsum32(float v) { auto r = __builtin_amdgcn_permlane32_swap(__float_as_uint(v), __float_as_uint(v), false, false); return __uint_as_float(r[0]) + __uint_as_float(r[1]); }
DI float xor32(float v) { return __shfl_xor(v, 32, 64); }
DI float max3f(float a, float b, float c) { float r; asm("v_max3_f32 %0, %1, %2, %3" : "=v"(r) : "v"(a), "v"(b), "v"(c)); return r; }
DI f32x16 zero16() { f32x16 z = {0.f, 0.f, 0.f, 0.f, 0.f, 0.f, 0.f, 0.f, 0.f, 0.f, 0.f, 0.f, 0.f, 0.f, 0.f, 0.f}; return z; }

DI bf16x8 pack_half(const f32x16& x, int s) {
  uint4 u;
  if (s == 0) { u.x = pack2(x[0], x[1]); u.y = pack2(x[2], x[3]); u.z = pack2(x[4], x[5]); u.w = pack2(x[6], x[7]); }
  else        { u.x = pack2(x[8], x[9]); u.y = pack2(x[10], x[11]); u.z = pack2(x[12], x[13]); u.w = pack2(x[14], x[15]); }
  return __builtin_bit_cast(bf16x8, u);
}

struct QF { bf16x8 q0, q1, q2, q3; };
DI f32x16 qk_tile(const bf16* sK, int kstride, const QF& qf, int l31, int hh) {
  f32x16 s = zero16();
  const bf16* r = sK + l31 * kstride + hh * 8;
  s = MFMA32(*(const bf16x8*)(r), qf.q0, s);
  s = MFMA32(*(const bf16x8*)(r + 16), qf.q1, s);
  s = MFMA32(*(const bf16x8*)(r + 32), qf.q2, s);
  s = MFMA32(*(const bf16x8*)(r + 48), qf.q3, s);
  return s;
}
DI void pv_tile(f32x16* o, const bf16* sVt, int vstride, bf16x8 p0, bf16x8 p1, int l31, int hh) {
#pragma unroll
  for (int et = 0; et < 2; ++et) {
#pragma unroll
    for (int s = 0; s < 2; ++s) {
      const bf16* row = sVt + (et * 32 + l31) * vstride + 16 * s + 4 * hh;
      s16x4 lo = *(const s16x4*)(row);
      s16x4 hi = *(const s16x4*)(row + 8);
      bf16x8 a = __builtin_shufflevector(lo, hi, 0, 1, 2, 3, 4, 5, 6, 7);
      o[et] = MFMA32(a, s == 0 ? p0 : p1, o[et]);
    }
  }
}

DI void phase_prologue(const Params& p) {
  const int gtid = blockIdx.x * 512 + threadIdx.x, gsz = gridDim.x * 512;
  for (int i0 = gtid; i0 < kT * kDM / 8; i0 += 4 * gsz) {
    float4 a[4], b[4];
#pragma unroll
    for (int j = 0; j < 4; ++j) {
      int ii = i0 + j * gsz; if (ii >= kT * kDM / 8) ii = i0;
      const float4* src = (const float4*)(p.x + (size_t)ii * 8);
      a[j] = src[0]; b[j] = src[1];
    }
#pragma unroll
    for (int j = 0; j < 4; ++j) {
      uint4 u; u.x = pack2(a[j].x, a[j].y); u.y = pack2(a[j].z, a[j].w); u.z = pack2(b[j].x, b[j].y); u.w = pack2(b[j].z, b[j].w);
      int ii = i0 + j * gsz; if (ii >= kT * kDM / 8) ii = i0;
      *(uint4*)(p.xb + (size_t)ii * 8) = u;
    }
  }
  for (int i = gtid; i < 2 * 128 * kNP; i += gsz) {
    int kcl = i & 7; int r0 = i >> 3; int n = r0 % kNP; int r = r0 / kNP; int kc = (r & 15) * 8 + kcl; int l = r >> 4;
    float v[8];
#pragma unroll
    for (int j = 0; j < 8; ++j) v[j] = (n < kDIN) ? p.w_in[((size_t)l * 1024 + kc * 8 + j) * kDIN + n] : 0.f;
    uint4 u; u.x = pack2(v[0], v[1]); u.y = pack2(v[2], v[3]); u.z = pack2(v[4], v[5]); u.w = pack2(v[6], v[7]);
    *(uint4*)(p.wint + ((size_t)l * kNP + n) * 1024 + kc * 8) = u;
  }
  for (int i = gtid; i < 2 * 128 * 1024; i += gsz) {
    int kcl = i & 7; int r0 = i >> 3; int n = r0 & 1023; int r = r0 >> 10; int kc = (r & 15) * 8 + kcl; int l = r >> 4;
    float v[8];
#pragma unroll
    for (int j = 0; j < 8; ++j) v[j] = p.w_out[((size_t)l * 1024 + kc * 8 + j) * 1024 + n];
    uint4 u; u.x = pack2(v[0], v[1]); u.y = pack2(v[2], v[3]); u.z = pack2(v[4], v[5]); u.w = pack2(v[6], v[7]);
    *(uint4*)(p.woutt + ((size_t)l * 1024 + n) * 1024 + kc * 8) = u;
  }
  for (int i = gtid; i < 4 * 256 * 64; i += gsz) {
    int kcl = i & 7; int r0 = i >> 3; int e = r0 & 63; int r = r0 >> 6; int kc = (r & 31) * 8 + kcl; int lk = r >> 5;
    float v[8];
#pragma unroll
    for (int j = 0; j < 8; ++j) v[j] = p.cmp_w[((size_t)lk * 2048 + kc * 8 + j) * 64 + e];
    uint4 u; u.x = pack2(v[0], v[1]); u.y = pack2(v[2], v[3]); u.z = pack2(v[4], v[5]); u.w = pack2(v[6], v[7]);
    *(uint4*)(p.cmpwt + ((size_t)lk * 64 + e) * 2048 + kc * 8) = u;
  }
  for (int i = gtid; i < 8 * 64 * 8; i += gsz) {
    int dc = i & 7; int e = (i >> 3) & 63; int ln = i >> 9;
    float va[8], vx[8];
#pragma unroll
    for (int j = 0; j < 8; ++j) { va[j] = p.w_a[(ln * 64 + dc * 8 + j) * 64 + e]; vx[j] = p.w_x[(ln * 64 + dc * 8 + j) * 64 + e]; }
    uint4 u; u.x = pack2(va[0], va[1]); u.y = pack2(va[2], va[3]); u.z = pack2(va[4], va[5]); u.w = pack2(va[6], va[7]);
    *(uint4*)(p.wat + (ln * 64 + e) * 64 + dc * 8) = u;
    u.x = pack2(vx[0], vx[1]); u.y = pack2(vx[2], vx[3]); u.z = pack2(vx[4], vx[5]); u.w = pack2(vx[6], vx[7]);
    *(uint4*)(p.wxt + (ln * 64 + e) * 64 + dc * 8) = u;
  }
  {
    const int lane = threadIdx.x & 63, gw = blockIdx.x * 8 + (threadIdx.x >> 6);
    if (gw < 64) {
      const int lk = gw >> 4, e0 = (gw & 15) * 4;
      float4 acc = make_float4(0.f, 0.f, 0.f, 0.f);
#pragma unroll 8
      for (int i = 0; i < 32; ++i) {
        int k = lane + 64 * i;
        float pz = p.cmp_pos[lk * 2048 + k];
        float4 wv = *(const float4*)(p.cmp_w + ((size_t)lk * 2048 + k) * 64 + e0);
        acc.x += pz * wv.x; acc.y += pz * wv.y; acc.z += pz * wv.z; acc.w += pz * wv.w;
      }
#pragma unroll
      for (int off = 32; off >= 1; off >>= 1) {
        acc.x += __shfl_xor(acc.x, off, 64); acc.y += __shfl_xor(acc.y, off, 64);
        acc.z += __shfl_xor(acc.z, off, 64); acc.w += __shfl_xor(acc.w, off, 64);
      }
      if (lane == 0) *(float4*)(p.cmpbp + gw * 32) = acc;
    }
  }
  for (int i = gtid; i < 4096 * 32; i += gsz) {
    int fi = i & 31, pos = i >> 5;
    float inv = (float)exp(-(double)fi * (9.210340371976184 / 32.0));
    float ang = (float)pos * inv;
    double rev = (double)ang * 0.15915494309189535;
    float fr = (float)(rev - rint(rev));
    float2 cs; cs.x = __builtin_amdgcn_cosf(fr); cs.y = __builtin_amdgcn_sinf(fr);
    ((float2*)p.rot)[i] = cs;
  }
}

template <int MODE>
DI void gemm_tile(const Params& p, int layer, int tm, int tn, char* lds) {
  int tid_ = threadIdx.x; asm volatile("" : "+v"(tid_));
  const int tid = tid_ & 255, lane = tid & 63, w = tid >> 6, l31 = lane & 31, hh = lane >> 5;
  bf16* sA = (bf16*)lds;
  if (tid_ >= 256) {
    const bf16* Ab = p.xb + (size_t)tm * 256 * 1024;
    const bf16* Bb = (MODE == 0 ? p.wint + (size_t)layer * kNP * 1024 : p.woutt + (size_t)layer * 1024 * 1024) + (size_t)tn * 128 * 1024;
    const int lrow = tid >> 3, lcc = tid & 7;
    const bf16* Ap = Ab + lrow * 1024 + lcc * 8;
    const bf16* Bp = Bb + lrow * 1024 + lcc * 8;
    uint4 Pa0, Pa1, Pa2, Pa3, Pa4, Pa5, Pa6, Pa7, Pb0, Pb1, Pb2, Pb3, Qa0, Qa1, Qa2, Qa3, Qa4, Qa5, Qa6, Qa7, Qb0, Qb1, Qb2, Qb3;
#define G_LOAD(R, kt_) { const bf16* Aq = Ap + (kt_) * 64; const bf16* Bq = Bp + (kt_) * 64; \
    R##a0 = *(const uint4*)(Aq); R##a1 = *(const uint4*)(Aq + 32 * 1024); R##a2 = *(const uint4*)(Aq + 64 * 1024); R##a3 = *(const uint4*)(Aq + 96 * 1024); \
    R##a4 = *(const uint4*)(Aq + 128 * 1024); R##a5 = *(const uint4*)(Aq + 160 * 1024); R##a6 = *(const uint4*)(Aq + 192 * 1024); R##a7 = *(const uint4*)(Aq + 224 * 1024); \
    R##b0 = *(const uint4*)(Bq); R##b1 = *(const uint4*)(Bq + 32 * 1024); R##b2 = *(const uint4*)(Bq + 64 * 1024); R##b3 = *(const uint4*)(Bq + 96 * 1024); }
#define G_STORE(R, buf_) { bf16* sAw = sA + (buf_) * (384 * LDK) + lrow * LDK + lcc * 8; bf16* sBw = sAw + 256 * LDK; \
    *(uint4*)(sAw) = R##a0; *(uint4*)(sAw + 32 * LDK) = R##a1; *(uint4*)(sAw + 64 * LDK) = R##a2; *(uint4*)(sAw + 96 * LDK) = R##a3; \
    *(uint4*)(sAw + 128 * LDK) = R##a4; *(uint4*)(sAw + 160 * LDK) = R##a5; *(uint4*)(sAw + 192 * LDK) = R##a6; *(uint4*)(sAw + 224 * LDK) = R##a7; \
    *(uint4*)(sBw) = R##b0; *(uint4*)(sBw + 32 * LDK) = R##b1; *(uint4*)(sBw + 64 * LDK) = R##b2; *(uint4*)(sBw + 96 * LDK) = R##b3; }
    G_LOAD(P, 0)
    __builtin_amdgcn_sched_barrier(0);
    G_LOAD(Q, 1)
    __builtin_amdgcn_sched_barrier(0);
    G_STORE(P, 0)
    G_LOAD(P, 2)
    __syncthreads();
#pragma unroll 1
    for (int kt = 0; kt < 16; kt += 2) {
      G_STORE(Q, 1)
      G_LOAD(Q, (kt + 3 < 16 ? kt + 3 : 15))
      __syncthreads();
      if (kt + 2 < 16) G_STORE(P, 0)
      G_LOAD(P, (kt + 4 < 16 ? kt + 4 : 15))
      __syncthreads();
    }
#undef G_LOAD
#undef G_STORE
    return;
  }
#define FR_LOAD(F, ks_) { F##b0 = *(const bf16x8*)(cB + (ks_) * 16); F##b1 = *(const bf16x8*)(cB + 32 * LDK + (ks_) * 16); \
      F##a0 = *(const bf16x8*)(cA + (ks_) * 16); F##a1 = *(const bf16x8*)(cA + 32 * LDK + (ks_) * 16); \
      F##a2 = *(const bf16x8*)(cA + 64 * LDK + (ks_) * 16); F##a3 = *(const bf16x8*)(cA + 96 * LDK + (ks_) * 16); }
#define FR_MMA(F) { if (MODE == 1) { \
      acc[0][0] = MFMA32(F##a0, F##b0, acc[0][0]); acc[0][1] = MFMA32(F##a0, F##b1, acc[0][1]); \
      acc[1][0] = MFMA32(F##a1, F##b0, acc[1][0]); acc[1][1] = MFMA32(F##a1, F##b1, acc[1][1]); \
      acc[2][0] = MFMA32(F##a2, F##b0, acc[2][0]); acc[2][1] = MFMA32(F##a2, F##b1, acc[2][1]); \
      acc[3][0] = MFMA32(F##a3, F##b0, acc[3][0]); acc[3][1] = MFMA32(F##a3, F##b1, acc[3][1]); \
    } else {     \
      acc[0][0] = MFMA32(F##b0, F##a0, acc[0][0]); acc[0][1] = MFMA32(F##b1, F##a0, acc[0][1]); \
      acc[1][0] = MFMA32(F##b0, F##a1, acc[1][0]); acc[1][1] = MFMA32(F##b1, F##a1, acc[1][1]); \
      acc[2][0] = MFMA32(F##b0, F##a2, acc[2][0]); acc[2][1] = MFMA32(F##b1, F##a2, acc[2][1]); \
      acc[3][0] = MFMA32(F##b0, F##a3, acc[3][0]); acc[3][1] = MFMA32(F##b1, F##a3, acc[3][1]); } }
  f32x16 acc[4][2];
#pragma unroll
  for (int mi = 0; mi < 4; ++mi) { acc[mi][0] = zero16(); acc[mi][1] = zero16(); }
  const int wm = w >> 1, wn = w & 1;
  __syncthreads();
#pragma unroll 1
  for (int kt = 0; kt < 16; ++kt) {
    const bf16* cA = sA + (kt & 1) * (384 * LDK) + (wm * 128 + l31) * LDK + hh * 8;
    const bf16* cB = sA + (kt & 1) * (384 * LDK) + (256 + wn * 64 + l31) * LDK + hh * 8;
    bf16x8 Xa0, Xa1, Xa2, Xa3, Xb0, Xb1, Ya0, Ya1, Ya2, Ya3, Yb0, Yb1;
    FR_LOAD(X, 0)
    FR_LOAD(Y, 1) __builtin_amdgcn_sched_barrier(0); FR_MMA(X) __builtin_amdgcn_sched_barrier(0);
    FR_LOAD(X, 2) __builtin_amdgcn_sched_barrier(0); FR_MMA(Y) __builtin_amdgcn_sched_barrier(0);
    FR_LOAD(Y, 3) __builtin_amdgcn_sched_barrier(0); FR_MMA(X) __builtin_amdgcn_sched_barrier(0);
    FR_MMA(Y)
    __syncthreads();
  }
#undef FR_LOAD
#undef FR_MMA
  const int m0 = tm * 256 + wm * 128, n0 = tn * 128 + wn * 64;
  if (MODE == 1) {
    const float* res = layer == 0 ? p.x : p.out;
    const float alpha = 1.41421356237f;
#pragma unroll
    for (int mi = 0; mi < 4; ++mi)
#pragma unroll
      for (int ni = 0; ni < 2; ++ni) {
        float rv[16];
#pragma unroll
        for (int i = 0; i < 16; ++i)
          rv[i] = res[(size_t)(m0 + mi * 32 + crow(i, hh)) * 1024 + n0 + ni * 32 + l31];
#pragma unroll
        for (int i = 0; i < 16; ++i)
          p.out[(size_t)(m0 + mi * 32 + crow(i, hh)) * 1024 + n0 + ni * 32 + l31] = alpha * rv[i] + acc[mi][ni][i];
      }
    return;
  }
  const int seg = n0 >> 6;
  const bool is_rot = seg < 8;
  const float scale = (seg >= 4 && seg < 8) ? 0.125f : ((seg >= 16 && seg < 24) ? 0.125f * 1.4426950408889634f : 1.f);
  bf16* tdst = nullptr; int hd = 0, nh = 1; float lg2g = 0.f;
  if (seg >= 4 && seg < 8) { tdst = p.kdt; hd = seg - 4; nh = 4; lg2g = log2f(1.f - exp2f(-5.f - (float)hd)); }
  else if (seg >= 8 && seg < 12) { tdst = p.vrt; hd = seg - 8; nh = 4; }
  else if (seg == 30 || seg == 31) { tdst = p.vst; hd = seg - 30; nh = 2; }
  else if (seg == 34 || seg == 35) { tdst = p.vwt; hd = seg - 34; nh = 2; }
  const bool natural = !((seg >= 8 && seg < 12) || seg == 30 || seg == 31 || seg == 34 || seg == 35);
#pragma unroll
  for (int mi = 0; mi < 4; ++mi) {
    const int row = m0 + mi * 32 + l31;
    const int bb = row >> 12, sq = row & 4095;
    if (is_rot) {
#pragma unroll
      for (int g4 = 0; g4 < 4; ++g4) {
        const float4* rp = (const float4*)(p.rot + ((size_t)sq * 32 + 8 * g4 + 4 * hh) * 2);
        float4 c01 = rp[0], c23 = rp[1];
        float cs[4] = {c01.x, c01.z, c23.x, c23.z}, sn[4] = {c01.y, c01.w, c23.y, c23.w};
#pragma unroll
        for (int j = 0; j < 4; ++j) {
          float v0 = acc[mi][0][g4 * 4 + j], v1 = acc[mi][1][g4 * 4 + j];
          acc[mi][0][g4 * 4 + j] = v0 * cs[j] - v1 * sn[j];
          acc[mi][1][g4 * 4 + j] = v0 * sn[j] + v1 * cs[j];
        }
      }
    }
    if (scale != 1.f) {
#pragma unroll
      for (int i = 0; i < 16; ++i) { acc[mi][0][i] *= scale; acc[mi][1][i] *= scale; }
    }
    if (natural) {
#pragma unroll
      for (int ni = 0; ni < 2; ++ni)
#pragma unroll
        for (int g4 = 0; g4 < 4; ++g4) {
          uint2 u; u.x = pack2(acc[mi][ni][g4 * 4 + 0], acc[mi][ni][g4 * 4 + 1]); u.y = pack2(acc[mi][ni][g4 * 4 + 2], acc[mi][ni][g4 * 4 + 3]);
          *(uint2*)(p.proj + (size_t)row * kNP + n0 + ni * 32 + 8 * g4 + 4 * hh) = u;
        }
    }
    if (tdst) {
      const float kd = (lg2g != 0.f) ? exp2f((float)(127 - (sq & 127)) * lg2g) : 1.f;
      bf16* tb = tdst + ((size_t)(bb * nh + hd) * 64) * 4096 + sq;
#pragma unroll
      for (int ni = 0; ni < 2; ++ni)
#pragma unroll
        for (int i = 0; i < 16; ++i)
          tb[(size_t)(ni * 32 + crow(i, hh)) * 4096] = f2bf(acc[mi][ni][i] * kd);
    }
  }
}

DI void ret_kv_unit(const Params& p, int u0) {
  int tid_ = threadIdx.x; asm volatile("" : "+v"(tid_));
  const int u = u0 + 256 * (tid_ >> 8);
  const int tid = tid_ & 255, lane = tid & 63, w = tid >> 6, l31 = lane & 31, hh = lane >> 5;
  const int bh = u >> 5, n = u & 31;
  const int mi = w >> 1, ni = w & 1;
  const bf16* ka = p.kdt + ((size_t)bh * 64 + mi * 32 + l31) * 4096 + n * 128 + hh * 8;
  const bf16* vb = p.vrt + ((size_t)bh * 64 + ni * 32 + l31) * 4096 + n * 128 + hh * 8;
  f32x16 acc = zero16();
#pragma unroll
  for (int ks = 0; ks < 8; ++ks) {
    bf16x8 a = *(const bf16x8*)(ka + ks * 16);
    bf16x8 b = *(const bf16x8*)(vb + ks * 16);
    acc = MFMA32(a, b, acc);
  }
#pragma unroll
  for (int i = 0; i < 16; ++i)
    p.kvc[(size_t)u * 4096 + (mi * 32 + crow(i, hh)) * 64 + ni * 32 + l31] = acc[i];
}

DI void nsa_cmp_unit(const Params& p, int layer, int u, char* lds) {
  if (threadIdx.x >= 256) {
    for (int i_ = 0; i_ < 2; ++i_) __syncthreads();
    return;
  }
  int tid_ = threadIdx.x; asm volatile("" : "+v"(tid_));
  const int tid = tid_, lane = tid & 63, w = tid >> 6, l31 = lane & 31, hh = lane >> 5;
  const int mb2 = u & 7, kv = (u >> 3) & 1, g = (u >> 4) & 1, b = u >> 5;
  const int mb = mb2 >> 1, mt0 = mb2 & 1;
  float* red = (float*)lds;
  const bf16* brow = p.cmpwt + ((size_t)(layer * 2 + kv) * 64 + l31) * 2048 + hh * 8;
  const float* bp = p.cmpbp + (layer * 2 + kv) * 16 * 32;
#pragma unroll 1
  for (int mt = mt0; mt <= mt0; ++mt) {
    int n = mb * 64 + mt * 32 + l31; int nc = n > 254 ? 254 : n;
    const bf16* arow = p.proj + ((size_t)(b * 4096 + 16 * nc)) * kNP + (kv ? C_NVC : C_NKC) + g * 64 + hh * 8;
    f32x16 acc0 = zero16(), acc1 = zero16();
#pragma unroll 4
    for (int lt = w * 8; lt < w * 8 + 8; ++lt) {
#pragma unroll
      for (int ks = 0; ks < 4; ++ks) {
        bf16x8 a = *(const bf16x8*)(arow + (size_t)lt * kNP + ks * 16);
        bf16x8 b0 = *(const bf16x8*)(brow + lt * 64 + ks * 16);
        bf16x8 b1 = *(const bf16x8*)(brow + 32 * 2048 + lt * 64 + ks * 16);
        acc0 = MFMA32(a, b0, acc0);
        acc1 = MFMA32(a, b1, acc1);
      }
    }
    __syncthreads();
#pragma unroll
    for (int i = 0; i < 16; ++i) {
      red[(w * 32 + crow(i, hh)) * 64 + l31] = acc0[i];
      red[(w * 32 + crow(i, hh)) * 64 + 32 + l31] = acc1[i];
    }
    __syncthreads();
    if (kv == 0) {
      for (int idx = tid; idx < 2048; idx += 256) {
        int e = idx & 63, r = idx >> 6;
        float sv = red[idx] + red[2048 + idx] + red[4096 + idx] + red[6144 + idx] + bp[(e >> 2) * 32 + (e & 3)];
        int nn = mb * 64 + mt * 32 + r;
        if (nn > 254) sv = 0.f;
        p.kc[((size_t)(b * 2 + g) * 256 + nn) * 64 + e] = f2bf(sv);
      }
    } else {
      for (int idx = tid; idx < 2048; idx += 256) {
        int r = idx & 31, e = idx >> 5;
        int ridx = r * 64 + e;
        float sv = red[ridx] + red[2048 + ridx] + red[4096 + ridx] + red[6144 + ridx] + bp[(e >> 2) * 32 + (e & 3)];
        int nn = mb * 64 + mt * 32 + r;
        if (nn > 254) sv = 0.f;
        p.vct[((size_t)(b * 2 + g) * 64 + e) * 256 + nn] = f2bf(sv);
      }
    }
  }
}

DI void lru_local_unit(const Params& p, int layer, int u, char* lds) {
  if (threadIdx.x >= 256) {
    for (int i_ = 0; i_ < 12; ++i_) __syncthreads();
    return;
  }
  int tid_ = threadIdx.x; asm volatile("" : "+v"(tid_));
  const int tid = tid_, lane = tid & 63, w = tid >> 6, l31 = lane & 31, hh = lane >> 5;
  const int half = u & 1, chunk = (u >> 1) & 31, b = u >> 6;
  bf16* xcb = (bf16*)lds;
  float* bufA = (float*)(lds + 32 * LDV * 2);
  float* bufU = bufA + 32 * 128;
  const int cl = tid & 127, tg = tid >> 7, chc = half * 128 + cl;
  const float cw0 = p.conv_w[(layer * 4 + 0) * 256 + chc], cw1 = p.conv_w[(layer * 4 + 1) * 256 + chc];
  const float cw2 = p.conv_w[(layer * 4 + 2) * 256 + chc], cw3 = p.conv_w[(layer * 4 + 3) * 256 + chc];
  const float cb = p.conv_b[layer * 256 + chc];
  const bf16* lx = p.proj + (size_t)(b * 4096) * kNP + C_LX + chc;
  const int nbl = w >> 1, ni = w & 1;
  const int nb = half * 2 + nbl;
  const bf16* wa = p.wat + ((size_t)(layer * 4 + nb) * 64 + ni * 32 + l31) * 64 + hh * 8;
  const bf16* wx = p.wxt + ((size_t)(layer * 4 + nb) * 64 + ni * 32 + l31) * 64 + hh * 8;
  const int chl = nbl * 64 + ni * 32 + l31, ch = half * 128 + chl;
  const float ba = p.b_a[layer * 256 + ch], bx = p.b_x[layer * 256 + ch];
  const float sp = log1pf(expf(-p.lam[layer * 256 + ch]));
  const bf16x8 wa0 = *(const bf16x8*)(wa), wa1 = *(const bf16x8*)(wa + 16), wa2 = *(const bf16x8*)(wa + 32), wa3 = *(const bf16x8*)(wa + 48);
  const bf16x8 wx0 = *(const bf16x8*)(wx), wx1 = *(const bf16x8*)(wx + 16), wx2 = *(const bf16x8*)(wx + 32), wx3 = *(const bf16x8*)(wx + 48);
  float hs = 0.f, As = 1.f;
  float xv[19];
  {
    const int s0 = chunk * 128 + tg * 16;
#pragma unroll
    for (int t = 0; t < 19; ++t) { int sidx = s0 - 3 + t; xv[t] = sidx >= 0 ? bf2f(lx[(size_t)sidx * kNP]) : 0.f; }
  }
#pragma unroll 1
  for (int sc = 0; sc < 4; ++sc) {
    __syncthreads();
    {
#pragma unroll
      for (int t = 0; t < 16; ++t) {
        float xc = xv[t] * cw0 + xv[t + 1] * cw1 + xv[t + 2] * cw2 + xv[t + 3] * cw3 + cb;
        xcb[(tg * 16 + t) * LDV + cl] = f2bf(xc);
        bufU[(tg * 16 + t) * 128 + cl] = xc;
      }
    }
    __syncthreads();
    if (sc < 3) {
      const int s1 = chunk * 128 + (sc + 1) * 32 + tg * 16;
#pragma unroll
      for (int t = 0; t < 19; ++t) xv[t] = bf2f(lx[(size_t)(s1 - 3 + t) * kNP]);
    }
    {
      f32x16 ra = zero16(), rx = zero16();
      {
        const bf16* xr = xcb + l31 * LDV + nbl * 64 + hh * 8;
        bf16x8 a0 = *(const bf16x8*)(xr), a1 = *(const bf16x8*)(xr + 16), a2 = *(const bf16x8*)(xr + 32), a3 = *(const bf16x8*)(xr + 48);
        ra = MFMA32(a0, wa0, ra); rx = MFMA32(a0, wx0, rx);
        ra = MFMA32(a1, wa1, ra); rx = MFMA32(a1, wx1, rx);
        ra = MFMA32(a2, wa2, ra); rx = MFMA32(a2, wx2, rx);
        ra = MFMA32(a3, wa3, ra); rx = MFMA32(a3, wx3, rx);
      }
#pragma unroll
      for (int i = 0; i < 16; ++i) {
        int t = crow(i, hh);
        float r = sigmoidf_(ra[i] + ba);
        float ig = sigmoidf_(rx[i] + bx);
        float log_a = -8.f * r * sp;
        float a = __expf(log_a);
        float xc = bufU[t * 128 + chl];
        float uu = __builtin_amdgcn_sqrtf(-expm1f(2.f * log_a)) * (ig * xc);
        bufA[t * 128 + chl] = a;
        bufU[t * 128 + chl] = uu;
      }
    }
    __syncthreads();
    if (tid < 128) {
      const size_t tokb = (size_t)b * 4096 + chunk * 128 + sc * 32;
#pragma unroll 8
      for (int t = 0; t < 32; ++t) {
        float a = bufA[t * 128 + tid], uu = bufU[t * 128 + tid];
        hs = a * hs + uu; As *= a;
        p.cuma[(tokb + t) * 256 + chc] = As;
        p.hloc[(tokb + t) * 256 + chc] = hs;
      }
    }
  }
  if (tid < 128) {
    p.suma[(b * 32 + chunk) * 256 + chc] = As;
    p.sumh[(b * 32 + chunk) * 256 + chc] = hs;
  }
}

DI void lru_out_unit(const Params& p, int u) {
  int tid_ = threadIdx.x; asm volatile("" : "+v"(tid_));
  const int tid = tid_;
  const int half = u & 1, chunk = (u >> 1) & 31, b = u >> 6;
  const int cl = tid & 127, tg = tid >> 7, ch = half * 128 + cl;
  float H = 0.f;
  {
    const float* sa = p.suma + (size_t)(b * 32) * 256 + ch;
    const float* sh = p.sumh + (size_t)(b * 32) * 256 + ch;
    int m = 0;
    for (; m + 8 <= chunk; m += 8) {
      float av[8], hv[8];
#pragma unroll
      for (int j = 0; j < 8; ++j) { av[j] = sa[(m + j) * 256]; hv[j] = sh[(m + j) * 256]; }
#pragma unroll
      for (int j = 0; j < 8; ++j) H = av[j] * H + hv[j];
    }
    for (; m < chunk; ++m) H = sa[m * 256] * H + sh[m * 256];
  }
  const size_t tok0 = (size_t)b * 4096 + chunk * 128 + tg * 32;
#pragma unroll 1
  for (int t8 = 0; t8 < 32; t8 += 8) {
    float hv[8], cv[8], gv[8];
#pragma unroll
    for (int j = 0; j < 8; ++j) {
      size_t tok = tok0 + t8 + j;
      hv[j] = p.hloc[tok * 256 + ch]; cv[j] = p.cuma[tok * 256 + ch]; gv[j] = bf2f(p.proj[tok * kNP + C_LG + ch]);
    }
#pragma unroll
    for (int j = 0; j < 8; ++j) {
      size_t tok = tok0 + t8 + j;
      p.xb[tok * 1024 + 768 + ch] = f2bf((hv[j] + cv[j] * H) * siluf_(gv[j]));
    }
  }
}

DI void ret_out_unit(const Params& p, int u0, char* lds0) {
  int tid_ = threadIdx.x; asm volatile("" : "+v"(tid_));
  const int vb = tid_ >> 8;
  const int u = u0 + 256 * vb;
  char* lds = lds0 + vb * 45056;
  const int tid = tid_ & 255, lane = tid & 63, w = tid >> 6, l31 = lane & 31, hh = lane >> 5;
  const int bh = u >> 5, n = u & 31, b = bh >> 2, h = bh & 3;
  bf16* sK = (bf16*)lds;
  bf16* sVt = sK + 128 * LDK;
  bf16* sSt = sVt + 64 * LDV;
  const int tok0 = b * 4096 + n * 128;
  const float lg2g = log2f(1.f - exp2f(-5.f - (float)h));
  __syncthreads();
#pragma unroll
  for (int i = 0; i < 4; ++i) {
    int c = tid + 256 * i;
    { int row = c >> 3, cc = c & 7;
      *(uint4*)(sK + row * LDK + cc * 8) = *(const uint4*)(p.proj + (size_t)(tok0 + row) * kNP + C_RK + h * 64 + cc * 8); }
    { int row = c >> 4, cc = c & 15;
      *(uint4*)(sVt + row * LDV + cc * 8) = *(const uint4*)(p.vrt + ((size_t)bh * 64 + row) * 4096 + n * 128 + cc * 8); }
  }
  {
    const float cd = exp2f(128.f * lg2g);
    float st[16];
#pragma unroll
    for (int j = 0; j < 16; ++j) st[j] = 0.f;
    const float* kvb = p.kvc + (size_t)(bh * 32) * 4096 + tid * 16;
    int m = 0;
    for (; m + 2 <= n; m += 2) {
      const float4* s0 = (const float4*)(kvb + (size_t)m * 4096);
      const float4* s1 = (const float4*)(kvb + (size_t)(m + 1) * 4096);
      float4 a0 = s0[0], a1 = s0[1], a2 = s0[2], a3 = s0[3];
      float4 c0 = s1[0], c1 = s1[1], c2 = s1[2], c3 = s1[3];
      st[0] = (st[0] * cd + a0.x) * cd + c0.x; st[1] = (st[1] * cd + a0.y) * cd + c0.y; st[2] = (st[2] * cd + a0.z) * cd + c0.z; st[3] = (st[3] * cd + a0.w) * cd + c0.w;
      st[4] = (st[4] * cd + a1.x) * cd + c1.x; st[5] = (st[5] * cd + a1.y) * cd + c1.y; st[6] = (st[6] * cd + a1.z) * cd + c1.z; st[7] = (st[7] * cd + a1.w) * cd + c1.w;
      st[8] = (st[8] * cd + a2.x) * cd + c2.x; st[9] = (st[9] * cd + a2.y) * cd + c2.y; st[10] = (st[10] * cd + a2.z) * cd + c2.z; st[11] = (st[11] * cd + a2.w) * cd + c2.w;
      st[12] = (st[12] * cd + a3.x) * cd + c3.x; st[13] = (st[13] * cd + a3.y) * cd + c3.y; st[14] = (st[14] * cd + a3.z) * cd + c3.z; st[15] = (st[15] * cd + a3.w) * cd + c3.w;
    }
    if (m < n) {
      const float4* src = (const float4*)(kvb + (size_t)m * 4096);
      float4 a0 = src[0], a1 = src[1], a2 = src[2], a3 = src[3];
      st[0] = st[0] * cd + a0.x; st[1] = st[1] * cd + a0.y; st[2] = st[2] * cd + a0.z; st[3] = st[3] * cd + a0.w;
      st[4] = st[4] * cd + a1.x; st[5] = st[5] * cd + a1.y; st[6] = st[6] * cd + a1.z; st[7] = st[7] * cd + a1.w;
      st[8] = st[8] * cd + a2.x; st[9] = st[9] * cd + a2.y; st[10] = st[10] * cd + a2.z; st[11] = st[11] * cd + a2.w;
      st[12] = st[12] * cd + a3.x; st[13] = st[13] * cd + a3.y; st[14] = st[14] * cd + a3.z; st[15] = st[15] * cd + a3.w;
    }
    const int d = tid >> 2, e0 = (tid & 3) * 16;
#pragma unroll
    for (int j = 0; j < 16; ++j) sSt[(e0 + j) * LDK + d] = f2bf(st[j]);
  }
  __syncthreads();
  const int qi = w * 32 + l31;
  const size_t tokq = (size_t)tok0 + qi;
  QF qf;
  {
    const bf16* qp = p.proj + tokq * kNP + C_RQ + h * 64 + hh * 8;
    qf.q0 = *(const bf16x8*)(qp); qf.q1 = *(const bf16x8*)(qp + 16); qf.q2 = *(const bf16x8*)(qp + 32); qf.q3 = *(const bf16x8*)(qp + 48);
  }
  f32x16 o[2];
  o[0] = zero16(); o[1] = zero16();
#pragma unroll
  for (int et = 0; et < 2; ++et) {
    const bf16* r = sSt + (et * 32 + l31) * LDK + hh * 8;
    o[et] = MFMA32(*(const bf16x8*)(r), qf.q0, o[et]);
    o[et] = MFMA32(*(const bf16x8*)(r + 16), qf.q1, o[et]);
    o[et] = MFMA32(*(const bf16x8*)(r + 32), qf.q2, o[et]);
    o[et] = MFMA32(*(const bf16x8*)(r + 48), qf.q3, o[et]);
  }
  const float qd = exp2f((float)(qi + 1) * lg2g);
#pragma unroll
  for (int i = 0; i < 16; ++i) { o[0][i] *= qd; o[1][i] *= qd; }
  for (int kt = 0; kt <= w; ++kt) {
    f32x16 s = qk_tile(sK + kt * 32 * LDK, LDK, qf, l31, hh);
#pragma unroll
    for (int i = 0; i < 16; ++i) {
      int key = kt * 32 + crow(i, hh);
      int diff = qi - key;
      s[i] = diff >= 0 ? s[i] * __builtin_amdgcn_exp2f((float)diff * lg2g) : 0.f;
    }
    bf16x8 p0 = pack_half(s, 0), p1 = pack_half(s, 1);
    pv_tile(o, sVt + kt * 32, LDV, p0, p1, l31, hh);
  }
  float s1 = 0.f;
#pragma unroll
  for (int i = 0; i < 16; ++i) s1 += o[0][i] + o[1][i];
  s1 = rsum32(s1);
  const float mean = s1 * (1.f / 64.f);
  float s2 = 0.f;
#pragma unroll
  for (int i = 0; i < 16; ++i) { float a = o[0][i] - mean, c = o[1][i] - mean; s2 += a * a + c * c; }
  s2 = rsum32(s2);
  const float rstd = rsqrtf(s2 * (1.f / 64.f) + 1e-5f);
  uint2 grv[2][4];
#pragma unroll
  for (int et = 0; et < 2; ++et)
#pragma unroll
    for (int g4 = 0; g4 < 4; ++g4) grv[et][g4] = *(const uint2*)(p.proj + tokq * kNP + C_RG + h * 64 + et * 32 + 8 * g4 + 4 * hh);
#pragma unroll
  for (int et = 0; et < 2; ++et)
#pragma unroll
    for (int g4 = 0; g4 < 4; ++g4) {
      int e = et * 32 + 8 * g4 + 4 * hh;
      uint2 gr = grv[et][g4];
      float g0 = __uint_as_float(gr.x << 16), g1 = __uint_as_float(gr.x & 0xffff0000u);
      float g2 = __uint_as_float(gr.y << 16), g3 = __uint_as_float(gr.y & 0xffff0000u);
      float y0 = (o[et][g4 * 4 + 0] - mean) * rstd * siluf_(g0);
      float y1 = (o[et][g4 * 4 + 1] - mean) * rstd * siluf_(g1);
      float y2 = (o[et][g4 * 4 + 2] - mean) * rstd * siluf_(g2);
      float y3 = (o[et][g4 * 4 + 3] - mean) * rstd * siluf_(g3);
      uint2 uo; uo.x = pack2(y0, y1); uo.y = pack2(y2, y3);
      *(uint2*)(p.xb + tokq * 1024 + h * 64 + e) = uo;
    }
}

#define KV_LOAD(kptr_, vptr_) { const bf16* kp_ = (kptr_); const bf16* vp_ = (vptr_); \
    rk0 = *(const uint4*)(kp_ + (size_t)lrow * kstride + lcc * 8); rk1 = *(const uint4*)(kp_ + (size_t)(lrow + 32) * kstride + lcc * 8); \
    rv0 = *(const uint4*)(vp_ + (size_t)lrow * vstride + lcc * 8); rv1 = *(const uint4*)(vp_ + (size_t)(lrow + 32) * vstride + lcc * 8); }

template <int MODE>
DI void nsa_branch(const bf16* kbase, int kstride, const bf16* vbase, int vstride, int jb_lo, int jb_hi, int full_lo, int full_hi,
                   bf16* sK0, bf16* sVt_unused, const QF& qf, int t, int nmax, unsigned sel_lo, unsigned sel_hi,
                   float& m, float& l, f32x16* o, float* imp_row, int tid, int l31, int hh, bool pre, uint4 pk, uint4 pv) {
  const int lrow = tid >> 3, lcc = tid & 7;
  uint4 rk0, rv0;
#define KV_LOAD8(kptr_, vptr_) { rk0 = *(const uint4*)((kptr_) + (size_t)lrow * kstride + lcc * 8); rv0 = *(const uint4*)((vptr_) + (size_t)lrow * vstride + lcc * 8); }
  if (pre) { rk0 = pk; rv0 = pv; }
  else KV_LOAD8(kbase + (size_t)jb_lo * 64 * kstride, vbase + jb_lo * 64)
  float inv_l = 0.f, carry = 0.f;
  if (MODE == 1) inv_l = l > 0.f ? 1.f / l : 0.f;
  __syncthreads();
  *(uint4*)(sK0 + lrow * LDK + lcc * 8) = rk0;
  *(uint4*)(sK0 + 64 * LDK + lrow * LDK + lcc * 8) = rv0;
  if (jb_lo < jb_hi) KV_LOAD8(kbase + (size_t)(jb_lo + 1) * 64 * kstride, vbase + (jb_lo + 1) * 64)
  __syncthreads();
#pragma unroll 1
  for (int jb = jb_lo; jb <= jb_hi; ++jb) {
    const int cur = (jb - jb_lo) & 1;
    const bf16* sK = sK0 + cur * (128 * LDK);
    const bf16* sVt = sK + 64 * LDK;
    if (jb < jb_hi) {
      bf16* dK = sK0 + (cur ^ 1) * (128 * LDK);
      *(uint4*)(dK + lrow * LDK + lcc * 8) = rk0;
      *(uint4*)(dK + 64 * LDK + lrow * LDK + lcc * 8) = rv0;
    }
    if (jb + 1 < jb_hi) KV_LOAD8(kbase + (size_t)(jb + 2) * 64 * kstride, vbase + (jb + 2) * 64)
    const bool full = (jb >= full_lo) && (jb <= full_hi);
    f32x16 s0 = qk_tile(sK, LDK, qf, l31, hh);
    f32x16 s1 = qk_tile(sK + 32 * LDK, LDK, qf, l31, hh);
    bool selb = true;
    if (MODE == 2) selb = ((jb < 32 ? sel_lo >> jb : sel_hi >> (jb - 32)) & 1u) != 0;
    if (!full) {
#pragma unroll
      for (int i = 0; i < 16; ++i) {
        const int key = jb * 64 + crow(i, hh);
        bool v0, v1;
        if (MODE <= 1) { v0 = key <= nmax; v1 = key + 32 <= nmax; }
        else if (MODE == 2) { v0 = selb && key <= t; v1 = selb && key + 32 <= t; }
        else { v0 = key <= t && key > t - 512; v1 = key + 32 <= t && key + 32 > t - 512; }
        s0[i] = v0 ? s0[i] : -1e30f;
        s1[i] = v1 ? s1[i] : -1e30f;
      }
    }
    if (MODE == 1) {
#pragma unroll
      for (int i = 0; i < 16; ++i) {
        float a0 = s0[i], a1 = s1[i];
        float p0 = __builtin_amdgcn_exp2f(a0 - m) * inv_l, p1 = __builtin_amdgcn_exp2f(a1 - m) * inv_l;
        s0[i] = (full || a0 > -1e29f) ? p0 : 0.f;
        s1[i] = (full || a1 > -1e29f) ? p1 : 0.f;
      }
#pragma unroll
      for (int sub = 0; sub < 2; ++sub) {
        const f32x16& pp = sub ? s1 : s0;
        float e0 = xor32x(pp[3], hh), e1 = xor32x(pp[7], hh), e2 = xor32x(pp[11], hh), e3 = xor32x(pp[15], hh);
        float r0 = hh ? e0 : carry, r1 = hh ? e1 : e0, r2 = hh ? e2 : e1, r3 = hh ? e3 : e2;
        carry = e3;
        float* dst = imp_row + ((jb * 64 + sub * 32) >> 2) + hh;
        dst[0] = 2.f * (pp[0] + pp[1] + pp[2]) + pp[3] + r0;
        dst[2] = 2.f * (pp[4] + pp[5] + pp[6]) + pp[7] + r1;
        dst[4] = 2.f * (pp[8] + pp[9] + pp[10]) + pp[11] + r2;
        dst[6] = 2.f * (pp[12] + pp[13] + pp[14]) + pp[15] + r3;
      }
    } else {
      float mx = -1e30f;
#pragma unroll
      for (int i = 0; i < 16; ++i) mx = max3f(mx, s0[i], s1[i]);
      mx = rmax32(mx);
      if (MODE == 2 && full) mx = selb ? mx : -1e30f;
      if (__any(mx > m + 8.f)) {
        const float m_new = fmaxf(m, mx);
        const float alpha = __builtin_amdgcn_exp2f(m - m_new);
        l *= alpha; m = m_new;
        if (MODE >= 2) {
#pragma unroll
          for (int i = 0; i < 16; ++i) { o[0][i] *= alpha; o[1][i] *= alpha; }
        }
      }
      const float msub = (MODE == 2 && full && !selb) ? 1e30f : m;
      const fl2_t m2 = {msub, msub};
      fl2_t rs2 = {0.f, 0.f};
#pragma unroll
      for (int i = 0; i < 16; i += 2) {
        fl2_t a = {s0[i], s0[i + 1]}, c = {s1[i], s1[i + 1]};
        fl2_t da = a - m2, dc = c - m2;
        fl2_t pa = {__builtin_amdgcn_exp2f(da.x), __builtin_amdgcn_exp2f(da.y)};
        fl2_t pc = {__builtin_amdgcn_exp2f(dc.x), __builtin_amdgcn_exp2f(dc.y)};
        if (!full) {
          pa.x = a.x > -1e29f ? pa.x : 0.f; pa.y = a.y > -1e29f ? pa.y : 0.f;
          pc.x = c.x > -1e29f ? pc.x : 0.f; pc.y = c.y > -1e29f ? pc.y : 0.f;
        }
        s0[i] = pa.x; s0[i + 1] = pa.y; s1[i] = pc.x; s1[i + 1] = pc.y;
        rs2 += pa; rs2 += pc;
      }
      l += rsum32(rs2.x + rs2.y);
    }
    if (MODE >= 1) {
      pv_tile(o, sVt, LDK, pack_half(s0, 0), pack_half(s0, 1), l31, hh);
      pv_tile(o, sVt + 32, LDK, pack_half(s1, 0), pack_half(s1, 1), l31, hh);
    }
    __syncthreads();
  }
#undef KV_LOAD8
}

DI void nsa_unit(const Params& p, int u, char* lds) {
  int tid_ = threadIdx.x; asm volatile("" : "+v"(tid_));
  const int tid = tid_, lane = tid & 63, w = tid >> 6, l31 = lane & 31, hh = lane >> 5;
  const int hw = w & 3, qs = w >> 2;
  const int qt = (u < 256) ? 63 - (u >> 3) : ((u - 256) >> 3), bg = u & 7, b = bg >> 1, g = bg & 1;
  const int t0 = qt * 64, t = t0 + qs * 32 + l31, c64 = t0 >> 6;
  const size_t tok = (size_t)b * 4096 + t;
  bf16* sK = (bf16*)lds;
  bf16* sVt = sK + 64 * LDK;
  float* imp = (float*)(lds + 4 * 64 * LDK * 2);
  unsigned* selm = (unsigned*)(imp + 4 * 64 * 64);
  const int head = g * 4 + hw;
  QF qf;
  {
    const bf16* qp = p.proj + tok * kNP + C_NQ + head * 64 + hh * 8;
    qf.q0 = *(const bf16x8*)(qp); qf.q1 = *(const bf16x8*)(qp + 16); qf.q2 = *(const bf16x8*)(qp + 32); qf.q3 = *(const bf16x8*)(qp + 48);
  }
  float gc, gs, gw;
  {
    const bf16* gp = p.proj + tok * kNP + C_NGL + head * 3;
    gc = sigmoidf_(bf2f(gp[0])); gs = sigmoidf_(bf2f(gp[1])); gw = sigmoidf_(bf2f(gp[2]));
  }
  f32x16 o[2];
  float m, l;
  const int nmax = (t - 31) >> 4;
  const int ncmp_tiles = (t0 / 16 + 3 + 63) >> 6;
  const int cfull_hi = ((((t0 - 31) >> 4) - 63) >> 6);
  const bf16* kcb = p.kc + (size_t)(b * 2 + g) * 256 * 64;
  const bf16* vcb = p.vct + (size_t)(b * 2 + g) * 64 * 256;
  float* imp_row = imp + hw * 4096 + (qs * 32 + l31) * 64;
  m = -1e30f; l = 0.f;
  const int lrow = tid >> 3, lcc = tid & 7;
  uint4 c2k = *(const uint4*)(kcb + (size_t)lrow * 64 + lcc * 8), c2v = *(const uint4*)(vcb + (size_t)lrow * 256 + lcc * 8);
  nsa_branch<0>(kcb, 64, vcb, 256, 0, ncmp_tiles - 1, 0, cfull_hi, sK, sVt, qf, t, nmax, 0u, 0u, m, l, o, nullptr, tid, l31, hh, false, c2k, c2v);
  o[0] = zero16(); o[1] = zero16();
  nsa_branch<1>(kcb, 64, vcb, 256, 0, ncmp_tiles - 1, 0, cfull_hi, sK, sVt, qf, t, nmax, 0u, 0u, m, l, o, imp_row, tid, l31, hh, true, c2k, c2v);
  __syncthreads();
  const bf16* kb_s = p.proj + (size_t)b * 4096 * kNP + C_NKS + g * 64;
  const bf16* vb_s = p.vst + (size_t)(b * 2 + g) * 64 * 4096;
  const bf16* kb_w = p.proj + (size_t)b * 4096 * kNP + C_NKW + g * 64;
  const bf16* vb_w = p.vwt + (size_t)(b * 2 + g) * 64 * 4096;
  const int jlo_w = c64 - 8 < 0 ? 0 : c64 - 8;
  const uint4 sk0 = *(const uint4*)(kb_s + (size_t)lrow * kNP + lcc * 8), sv0 = *(const uint4*)(vb_s + (size_t)lrow * 4096 + lcc * 8);
  const uint4 wk0 = *(const uint4*)(kb_w + (size_t)(jlo_w * 64 + lrow) * kNP + lcc * 8), wv0 = *(const uint4*)(vb_w + (size_t)lrow * 4096 + jlo_w * 64 + lcc * 8);
#pragma unroll 1
  for (int qi = 0; qi < 8; ++qi) {
    const int q = w * 8 + qi, j = lane;
    float v = imp[(0 * 64 + q) * 64 + j] + imp[(1 * 64 + q) * 64 + j] + imp[(2 * 64 + q) * 64 + j] + imp[(3 * 64 + q) * 64 + j];
    const bool causal = j <= c64;
    const bool forced = (j == 0) | (j == c64) | (j == c64 - 1);
    v = forced ? 1.0e4f : (causal ? v : 0.f);
    const unsigned key = causal ? ((__float_as_uint(v) & ~63u) | (unsigned)(63 - j)) : 0u;
    int rank = 0;
#pragma unroll
    for (int i = 0; i < 64; ++i) {
      unsigned ki = __builtin_amdgcn_readlane(key, i);
      rank += (ki > key) ? 1 : 0;
    }
    const bool sel = (rank < 16) & causal;
    unsigned long long mk = __ballot(sel);
    if (lane == 0) { selm[q * 2] = (unsigned)mk; selm[q * 2 + 1] = (unsigned)(mk >> 32); }
  }
  __syncthreads();
  const unsigned sel_lo = selm[(qs * 32 + l31) * 2], sel_hi = selm[(qs * 32 + l31) * 2 + 1];
  float* rs_ = imp + w * 2048 + lane;
#pragma unroll
  for (int et = 0; et < 2; ++et)
#pragma unroll
    for (int i = 0; i < 16; ++i) rs_[(et * 16 + i) * 64] = gc * o[et][i];
  {
    m = -1e30f; l = 0.f; o[0] = zero16(); o[1] = zero16();
    const bf16* kb = p.proj + (size_t)b * 4096 * kNP + C_NKS + g * 64;
    const bf16* vb = p.vst + (size_t)(b * 2 + g) * 64 * 4096;
    nsa_branch<2>(kb, kNP, vb, 4096, 0, c64, 0, c64 - 1, sK, sVt, qf, t, 0, sel_lo, sel_hi, m, l, o, nullptr, tid, l31, hh, true, sk0, sv0);
    const float sc = gs / l;
#pragma unroll
    for (int et = 0; et < 2; ++et)
#pragma unroll
      for (int i = 0; i < 16; ++i) rs_[(et * 16 + i) * 64] += sc * o[et][i];
  }
  {
    m = -1e30f; l = 0.f; o[0] = zero16(); o[1] = zero16();
    const bf16* kb = p.proj + (size_t)b * 4096 * kNP + C_NKW + g * 64;
    const bf16* vb = p.vwt + (size_t)(b * 2 + g) * 64 * 4096;
    const int jlo = c64 - 8 < 0 ? 0 : c64 - 8;
    const int flo = c64 - 7 < 0 ? 0 : c64 - 7;
    nsa_branch<3>(kb, kNP, vb, 4096, jlo, c64, flo, c64 - 1, sK, sVt, qf, t, 0, 0u, 0u, m, l, o, nullptr, tid, l31, hh, true, wk0, wv0);
    const float sc = gw / l;
#pragma unroll
    for (int et = 0; et < 2; ++et)
#pragma unroll
      for (int i = 0; i < 16; ++i) o[et][i] = rs_[(et * 16 + i) * 64] + sc * o[et][i];
  }
  uint2 grv[2][4];
#pragma unroll
  for (int et = 0; et < 2; ++et)
#pragma unroll
    for (int g4 = 0; g4 < 4; ++g4)
      grv[et][g4] = *(const uint2*)(p.proj + tok * kNP + C_NG + head * 64 + et * 32 + 8 * g4 + 4 * hh);
#pragma unroll
  for (int et = 0; et < 2; ++et)
#pragma unroll
    for (int g4 = 0; g4 < 4; ++g4) {
      const int e = et * 32 + 8 * g4 + 4 * hh;
      uint2 gr = grv[et][g4];
      float g0 = __uint_as_float(gr.x << 16), g1 = __uint_as_float(gr.x & 0xffff0000u);
      float g2 = __uint_as_float(gr.y << 16), g3 = __uint_as_float(gr.y & 0xffff0000u);
      uint2 uo;
      uo.x = pack2(o[et][g4 * 4 + 0] * siluf_(g0), o[et][g4 * 4 + 1] * siluf_(g1));
      uo.y = pack2(o[et][g4 * 4 + 2] * siluf_(g2), o[et][g4 * 4 + 3] * siluf_(g3));
      *(uint2*)(p.xb + tok * 1024 + 256 + head * 64 + e) = uo;
    }
}

DI void ln_phase(const Params& p, int layer) {
  int tid_ = threadIdx.x; asm volatile("" : "+v"(tid_));
  const int lane = tid_ & 63, w = tid_ >> 6;
  float4 ggv[4], bbv[4];
#pragma unroll
  for (int i = 0; i < 4; ++i) {
    ggv[i] = *(const float4*)(p.ln_g + layer * 1024 + (i * 64 + lane) * 4);
    bbv[i] = *(const float4*)(p.ln_b + layer * 1024 + (i * 64 + lane) * 4);
  }
  const int nwaves = gridDim.x * 8;
  constexpr int R = 4;
  for (int row0 = blockIdx.x * 8 + w; row0 < kT; row0 += R * nwaves) {
    float4 v[R][4];
    float sm[R], q[R], mean[R];
#pragma unroll
    for (int r = 0; r < R; ++r) {
      int row = row0 + r * nwaves; if (row >= kT) row = row0;
      sm[r] = 0.f;
#pragma unroll
      for (int i = 0; i < 4; ++i) {
        v[r][i] = *(const float4*)(p.out + (size_t)row * 1024 + (i * 64 + lane) * 4);
        sm[r] += v[r][i].x + v[r][i].y + v[r][i].z + v[r][i].w;
      }
    }
#pragma unroll
    for (int off = 32; off >= 1; off >>= 1) {
#pragma unroll
      for (int r = 0; r < R; ++r) sm[r] += __shfl_xor(sm[r], off, 64);
    }
#pragma unroll
    for (int r = 0; r < R; ++r) {
      mean[r] = sm[r] * (1.f / 1024.f); q[r] = 0.f;
#pragma unroll
      for (int i = 0; i < 4; ++i) {
        float a = v[r][i].x - mean[r], b = v[r][i].y - mean[r], c = v[r][i].z - mean[r], d = v[r][i].w - mean[r];
        q[r] += a * a + b * b + c * c + d * d;
      }
    }
#pragma unroll
    for (int off = 32; off >= 1; off >>= 1) {
#pragma unroll
      for (int r = 0; r < R; ++r) q[r] += __shfl_xor(q[r], off, 64);
    }
#pragma unroll
    for (int r = 0; r < R; ++r) {
      const int row = row0 + r * nwaves;
      if (row < kT) {
        const float rstd = rsqrtf(q[r] * (1.f / 1024.f) + 1e-5f);
#pragma unroll
        for (int i = 0; i < 4; ++i) {
          int col = (i * 64 + lane) * 4;
          float4 gg = ggv[i], bb = bbv[i];
          float4 y;
          y.x = (v[r][i].x - mean[r]) * rstd * gg.x + bb.x; y.y = (v[r][i].y - mean[r]) * rstd * gg.y + bb.y;
          y.z = (v[r][i].z - mean[r]) * rstd * gg.z + bb.z; y.w = (v[r][i].w - mean[r]) * rstd * gg.w + bb.w;
          *(float4*)(p.out + (size_t)row * 1024 + col) = y;
          if (layer == 0) {
            uint2 ub; ub.x = pack2(y.x, y.y); ub.y = pack2(y.z, y.w);
            *(uint2*)(p.xb + (size_t)row * 1024 + col) = ub;
          }
        }
      }
    }
  }
}

DI unsigned bar_ld(unsigned* q) { return __hip_atomic_load(q, __ATOMIC_RELAXED, __HIP_MEMORY_SCOPE_AGENT); }
DI unsigned bar_add(unsigned* q, unsigned v) { return __hip_atomic_fetch_add(q, v, __ATOMIC_RELAXED, __HIP_MEMORY_SCOPE_AGENT); }
DI unsigned xcc_id() { return (unsigned)__builtin_amdgcn_s_getreg((3 << 11) | 20) & 0xFu; }

DI void grid_barrier(unsigned* ctr, unsigned target) {
  asm volatile("s_waitcnt vmcnt(0)" ::: "memory");
  __syncthreads();
  if (threadIdx.x == 0) {
    __builtin_amdgcn_fence(__ATOMIC_RELEASE, "agent");
    asm volatile("s_waitcnt vmcnt(0)" ::: "memory");
    bar_add(ctr, 1u);
    while (bar_ld(ctr) < target) __builtin_amdgcn_s_sleep(1);
    __builtin_amdgcn_fence(__ATOMIC_ACQUIRE, "agent");
    asm volatile("s_waitcnt vmcnt(0)" ::: "memory");
  }
  __syncthreads();
}

DI void xcd_barrier(unsigned* bar, unsigned xcc, unsigned nloc, unsigned nx, unsigned k) {
  asm volatile("s_waitcnt vmcnt(0)" ::: "memory");
  __syncthreads();
  if (threadIdx.x == 0) {
    const unsigned old = bar_add(&bar[1024 + 64 * xcc], 1u);
    if (old + 1u == k * nloc) {
      __builtin_amdgcn_fence(__ATOMIC_RELEASE, "agent");
      asm volatile("s_waitcnt vmcnt(0)" ::: "memory");
      const unsigned og = bar_add(&bar[3072], 1u);
      if (og + 1u == k * nx) bar_add(&bar[3136], 1u);
      else while (bar_ld(&bar[3136]) < k) __builtin_amdgcn_s_sleep(1);
      __builtin_amdgcn_fence(__ATOMIC_ACQUIRE, "agent");
      bar_add(&bar[2048 + 64 * xcc], 1u);
      asm volatile("s_waitcnt vmcnt(0)" ::: "memory");
    } else {
      while (bar_ld(&bar[2048 + 64 * xcc]) < k) __builtin_amdgcn_s_sleep(1);
      __builtin_amdgcn_fence(__ATOMIC_ACQUIRE, "agent");
      asm volatile("s_waitcnt vmcnt(0)" ::: "memory");
    }
  }
  __syncthreads();
}

__global__ void __launch_bounds__(512) mega(Params p) {
  __shared__ __attribute__((aligned(16))) char lds[LDS_BYTES];
  __shared__ unsigned bst[4];
  cg::grid_group grid = cg::this_grid();
  const int G = gridDim.x, bid = blockIdx.x;
  if (p.bar == nullptr) grid.sync();
  const unsigned xcc = xcc_id();
  if (threadIdx.x == 0) bar_add(&p.bar[64 * xcc], 1u);
  phase_prologue(p);
  grid_barrier(&p.bar[3200], (unsigned)G);
  if (threadIdx.x == 0) {
    unsigned mine = 0, cnt = 0;
    for (unsigned j = 0; j < 16; ++j) { const unsigned c = bar_ld(&p.bar[64 * j]); cnt += c > 0u ? 1u : 0u; mine = (j == xcc) ? c : mine; }
    bst[0] = mine; bst[1] = cnt;
  }
  __syncthreads();
  const unsigned nloc = bst[0], nx = bst[1];
  unsigned nbar = 0;
  const int GW = G; const int wb = bid;
#define GRID_BARRIER() { ++nbar; xcd_barrier(p.bar, xcc, nloc, nx, nbar); }
#pragma unroll 1
  for (int layer = 0; layer < 2; ++layer) {
    __syncthreads();
    if (G == 256) {
      const int xcd = bid & 7, slot = bid >> 3;
#pragma unroll 1
      for (int li = slot; li < 216; li += 32) {
        const int half = li / 108, rem = li % 108;
        gemm_tile<0>(p, layer, xcd * 8 + half * 4 + (rem & 3), rem >> 2, lds);
      }
    } else {
#pragma unroll 1
      for (int tile = wb; tile < 64 * 27; tile += GW) gemm_tile<0>(p, layer, tile / 27, tile % 27, lds);
    }
    GRID_BARRIER()
#pragma unroll 1
    for (int u = (G == 256 ? (bid + 128) & 255 : wb); u < 128; u += GW) nsa_cmp_unit(p, layer, u, lds);
#pragma unroll 1
    for (int u = wb; u < 256; u += GW) lru_local_unit(p, layer, u, lds);
#pragma unroll 1
    for (int u = wb; u < 256; u += GW) ret_kv_unit(p, u);
    GRID_BARRIER()
#pragma unroll 1
    for (int u = wb; u < 512; u += GW) nsa_unit(p, u, lds);
#pragma unroll 1
    for (int u = wb; u < 256; u += GW) ret_out_unit(p, u, lds);
#pragma unroll 1
    for (int u = wb; u < 256; u += GW) lru_out_unit(p, u);
    GRID_BARRIER()
    __syncthreads();
    if (G == 256) {
      const int xcd = bid & 7, slot = bid >> 3;
#pragma unroll 1
      for (int li = slot; li < 64; li += 32)
        gemm_tile<1>(p, layer, xcd * 8 + (li >> 5) * 4 + (li & 3), (li >> 2) & 7, lds);
    } else {
#pragma unroll 1
      for (int tile = wb; tile < 64 * 8; tile += GW) gemm_tile<1>(p, layer, tile >> 3, tile & 7, lds);
    }
    GRID_BARRIER()
    ln_phase(p, layer);
    if (layer == 0) GRID_BARRIER()
  }
#undef GRID_BARRIER
}

extern "C" void kernel_launch(void* const* d_in, const int* in_sizes, int n_in, void* d_out, int out_size, void* d_ws,
                              size_t ws_size, hipStream_t stream) {
  static int grid_blocks = 0;
  if (!grid_blocks) {
    int dev = 0, cus = 0, per_cu = 0;
    (void)hipGetDevice(&dev);
    (void)hipDeviceGetAttribute(&cus, hipDeviceAttributeMultiprocessorCount, dev);
    (void)hipOccupancyMaxActiveBlocksPerMultiprocessor(&per_cu, mega, 512, 0);
    if (per_cu > 1) per_cu = 1;
    if (per_cu < 1) per_cu = 1;
    grid_blocks = cus * per_cu;
  }
  Params p{};
  p.x = (const float*)d_in[0]; p.w_in = (const float*)d_in[1]; p.w_out = (const float*)d_in[2];
  p.ln_g = (const float*)d_in[3]; p.ln_b = (const float*)d_in[4]; p.cmp_pos = (const float*)d_in[5];
  p.cmp_w = (const float*)d_in[6]; p.conv_w = (const float*)d_in[7]; p.conv_b = (const float*)d_in[8];
  p.w_a = (const float*)d_in[9]; p.b_a = (const float*)d_in[10]; p.w_x = (const float*)d_in[11];
  p.b_x = (const float*)d_in[12]; p.lam = (const float*)d_in[13];
  p.out = (float*)d_out;
  char* ws = (char*)d_ws;
  size_t off = 0;
  auto take = [&](size_t bytes) { char* r = ws + off; off += (bytes + 255) & ~(size_t)255; return r; };
  p.xb = (bf16*)take((size_t)kT * 1024 * 2);
  p.wint = (bf16*)take((size_t)2 * kNP * 1024 * 2);
  p.woutt = (bf16*)take((size_t)2 * 1024 * 1024 * 2);
  p.cmpwt = (bf16*)take((size_t)4 * 64 * 2048 * 2);
  p.proj = (bf16*)take((size_t)kT * kNP * 2);
  p.kdt = (bf16*)take((size_t)16 * 64 * 4096 * 2);
  p.vrt = (bf16*)take((size_t)16 * 64 * 4096 * 2);
  p.vst = (bf16*)take((size_t)8 * 64 * 4096 * 2);
  p.vwt = (bf16*)take((size_t)8 * 64 * 4096 * 2);
  p.kc = (bf16*)take((size_t)8 * 256 * 64 * 2);
  p.vct = (bf16*)take((size_t)8 * 64 * 256 * 2);
  p.wat = (bf16*)take((size_t)8 * 64 * 64 * 2);
  p.wxt = (bf16*)take((size_t)8 * 64 * 64 * 2);
  p.cmpbp = (float*)take((size_t)64 * 32 * 4);
  p.rot = (float*)take((size_t)4096 * 32 * 2 * 4);
  p.kvc = (float*)take((size_t)512 * 4096 * 4);
  p.cuma = (float*)take((size_t)kT * 256 * 4);
  p.hloc = (float*)take((size_t)kT * 256 * 4);
  p.suma = (float*)take((size_t)4 * 128 * 256 * 4);
  p.sumh = (float*)take((size_t)4 * 128 * 256 * 4);
  p.bar = (unsigned*)take(16384);
  if (off > ws_size) { fprintf(stderr, "workspace too small: need %zu have %zu\n", off, ws_size); return; }
  (void)hipMemsetAsync(p.bar, 0, 16384, stream);
  void* args[] = {&p};
  hipError_t e = hipLaunchCooperativeKernel((void*)mega, dim3(grid_blocks), dim3(512), args, 0, stream);
  if (e != hipSuccess) fprintf(stderr, "cooperative launch failed: %s (grid %d)\n", hipGetErrorString(e), grid_blocks);
}
```

```cpp
#include <hip/hip_runtime.h>
#include <hip/hip_cooperative_groups.h>
#include <stdint.h>
#include <cstdio>
namespace cg = cooperative_groups;

typedef unsigned short bf16;
typedef __attribute__((ext_vector_type(8))) short bf16x8;
typedef __attribute__((ext_vector_type(4))) short s16x4;
typedef __attribute__((ext_vector_type(16))) float f32x16;
typedef __bf16 bf2_t __attribute__((ext_vector_type(2)));
typedef float fl2_t __attribute__((ext_vector_type(2)));
#define DI __device__ __forceinline__
#define MFMA32(a, b, c) __builtin_amdgcn_mfma_f32_32x32x16_bf16((a), (b), (c), 0, 0, 0)

#ifndef USE_CG
#define USE_CG 0
#endif
#ifndef COOP
#define COOP 1
#endif

constexpr int kT = 16384, kS = 4096, kDM = 1024, kNP = 3456, kDIN = 3352, kNW = 3584;
constexpr int LDK = 72;
constexpr int LDV = 136;
constexpr int LDS_BYTES = 131072;
constexpr int NPHASE = 11;

constexpr int C_RQ = 0, C_RK = 256, C_RV = 512, C_RG = 768, C_NQ = 1024, C_NKC = 1536, C_NVC = 1664, C_NKS = 1792,
              C_NVS = 1920, C_NKW = 2048, C_NVW = 2176, C_NG = 2304, C_NGL = 2816, C_LX = 2840, C_LG = 3096;

struct Params {
  const float *x, *w_in, *w_out, *ln_g, *ln_b, *cmp_pos, *cmp_w, *conv_w, *conv_b, *w_a, *b_a, *w_x, *b_x, *lam;
  float* out;
  bf16 *xb, *wint, *woutt, *cmpwt, *proj, *kdt, *vrt, *vst, *vwt, *kc, *vct, *wat, *wxt;
  float *cmpbp, *rot, *kvc, *cuma, *hloc, *suma, *sumh;
  unsigned* bar;
};

DI unsigned pack2(float a, float b) { fl2_t f = {a, b}; bf2_t r = __builtin_convertvector(f, bf2_t); return __builtin_bit_cast(unsigned, r); }
DI bf16 f2bf(float a) { return (bf16)(pack2(a, 0.f) & 0xffffu); }
DI float bf2f(bf16 b) { return __uint_as_float(((unsigned)b) << 16); }
DI int crow(int i, int hh) { return (i & 3) + 8 * (i >> 2) + 4 * hh; }
DI float sigmoidf_(float x) { return 1.f / (1.f + __expf(-x)); }
DI float siluf_(float x) { return x / (1.f + __expf(-x)); }
DI float xor32x(float v, int hh) {
  auto r = __builtin_amdgcn_permlane32_swap(__float_as_uint(v), __float_as_uint(v), false, false);
  return __uint_as_float(hh ? r[0] : r[1]);
}
DI float rmax32(float v) { auto r = __builtin_amdgcn_permlane32_swap(__float_as_uint(v), __float_as_uint(v), false, false); return fmaxf(__uint_as_float(r[0]), __uint_as_float(r[1])); }
DI float rsum32(float v) { auto r = __builtin_amdgcn_permlane32_swap(__float_as_uint(v), __float_as_uint(v), false, false); return __uint_as_float(r[0]) + __uint_as_float(r[1]); }
DI float xor32(float v) { return __shfl_xor(v, 32, 64); }
DI float max3f(float a, float b, float c) { float r; asm("v_max3_f32 %0, %1, %2, %3" : "=v"(r) : "v"(a), "v"(b), "v"(c)); return r; }
DI f32x16 zero16() { f32x16 z = {0.f, 0.f, 0.f, 0.f, 0.f, 0.f, 0.f, 0.f, 0.f, 0.f, 0.f, 0.f, 0.f, 0.f, 0.f, 0.f}; return z; }

DI bf16x8 pack_half(const f32x16& x, int s) {
  uint4 u;
  if (s == 0) { u.x = pack2(x[0], x[1]); u.y = pack2(x[2], x[3]); u.z = pack2(x[4], x[5]); u.w = pack2(x[6], x[7]); }
  else        { u.x = pack2(x[8], x[9]); u.y = pack2(x[10], x[11]); u.z = pack2(x[12], x[13]); u.w = pack2(x[14], x[15]); }
  return __builtin_bit_cast(bf16x8, u);
}

struct QF { bf16x8 q0, q1, q2, q3; };
DI f32x16 qk_tile(const bf16* sK, int kstride, const QF& qf, int l31, int hh) {
  f32x16 s = zero16();
  const bf16* r = sK + l31 * kstride + hh * 8;
  s = MFMA32(*(const bf16x8*)(r), qf.q0, s);
  s = MFMA32(*(const bf16x8*)(r + 16), qf.q1, s);
  s = MFMA32(*(const bf16x8*)(r + 32), qf.q2, s);
  s = MFMA32(*(const bf16x8*)(r + 48), qf.q3, s);
  return s;
}
DI void pv_tile(f32x16* o, const bf16* sVt, int vstride, bf16x8 p0, bf16x8 p1, int l31, int hh) {
#pragma unroll
  for (int et = 0; et < 2; ++et) {
#pragma unroll
    for (int s = 0; s < 2; ++s) {
      const bf16* row = sVt + (et * 32 + l31) * vstride + 16 * s + 4 * hh;
      s16x4 lo = *(const s16x4*)(row);
      s16x4 hi = *(const s16x4*)(row + 8);
      bf16x8 a = __builtin_shufflevector(lo, hi, 0, 1, 2, 3, 4, 5, 6, 7);
      o[et] = MFMA32(a, s == 0 ? p0 : p1, o[et]);
    }
  }
}

DI void phase_prologue(const Params& p) {
  const int gtid = blockIdx.x * 512 + threadIdx.x, gsz = gridDim.x * 512;
  for (int i0 = gtid; i0 < kT * kDM / 8; i0 += 4 * gsz) {
    float4 a[4], b[4];
#pragma unroll
    for (int j = 0; j < 4; ++j) {
      int ii = i0 + j * gsz; if (ii >= kT * kDM / 8) ii = i0;
      const float4* src = (const float4*)(p.x + (size_t)ii * 8);
      a[j] = src[0]; b[j] = src[1];
    }
#pragma unroll
    for (int j = 0; j < 4; ++j) {
      uint4 u; u.x = pack2(a[j].x, a[j].y); u.y = pack2(a[j].z, a[j].w); u.z = pack2(b[j].x, b[j].y); u.w = pack2(b[j].z, b[j].w);
      int ii = i0 + j * gsz; if (ii >= kT * kDM / 8) ii = i0;
      *(uint4*)(p.xb + (size_t)ii * 8) = u;
    }
  }
  for (int i = gtid; i < 2 * 128 * kNW; i += gsz) {
    int kcl = i & 7; int r0 = i >> 3; int np = r0 % kNW; int r = r0 / kNW; int kc = (r & 15) * 8 + kcl; int l = r >> 4;
    const int pp = np & 63;
    const int n = (np & ~63) + 16 * ((pp >> 5) & 1) + (pp & 15) + 32 * ((pp >> 4) & 1);
    float v[8];
#pragma unroll
    for (int j = 0; j < 8; ++j) v[j] = (n < kDIN) ? p.w_in[((size_t)l * 1024 + kc * 8 + j) * kDIN + n] : 0.f;
    uint4 u; u.x = pack2(v[0], v[1]); u.y = pack2(v[2], v[3]); u.z = pack2(v[4], v[5]); u.w = pack2(v[6], v[7]);
    *(uint4*)(p.wint + ((size_t)l * kNW + np) * 1024 + kc * 8) = u;
  }
  for (int i = gtid; i < 2 * 128 * 1024; i += gsz) {
    int kcl = i & 7; int r0 = i >> 3; int n = r0 & 1023; int r = r0 >> 10; int kc = (r & 15) * 8 + kcl; int l = r >> 4;
    float v[8];
#pragma unroll
    for (int j = 0; j < 8; ++j) v[j] = p.w_out[((size_t)l * 1024 + kc * 8 + j) * 1024 + n];
    uint4 u; u.x = pack2(v[0], v[1]); u.y = pack2(v[2], v[3]); u.z = pack2(v[4], v[5]); u.w = pack2(v[6], v[7]);
    *(uint4*)(p.woutt + ((size_t)l * 1024 + n) * 1024 + kc * 8) = u;
  }
  for (int i = gtid; i < 4 * 256 * 64; i += gsz) {
    int kcl = i & 7; int r0 = i >> 3; int e = r0 & 63; int r = r0 >> 6; int kc = (r & 31) * 8 + kcl; int lk = r >> 5;
    float v[8];
#pragma unroll
    for (int j = 0; j < 8; ++j) v[j] = p.cmp_w[((size_t)lk * 2048 + kc * 8 + j) * 64 + e];
    uint4 u; u.x = pack2(v[0], v[1]); u.y = pack2(v[2], v[3]); u.z = pack2(v[4], v[5]); u.w = pack2(v[6], v[7]);
    *(uint4*)(p.cmpwt + ((size_t)lk * 64 + e) * 2048 + kc * 8) = u;
  }
  for (int i = gtid; i < 8 * 64 * 8; i += gsz) {
    int dc = i & 7; int e = (i >> 3) & 63; int ln = i >> 9;
    float va[8], vx[8];
#pragma unroll
    for (int j = 0; j < 8; ++j) { va[j] = p.w_a[(ln * 64 + dc * 8 + j) * 64 + e]; vx[j] = p.w_x[(ln * 64 + dc * 8 + j) * 64 + e]; }
    uint4 u; u.x = pack2(va[0], va[1]); u.y = pack2(va[2], va[3]); u.z = pack2(va[4], va[5]); u.w = pack2(va[6], va[7]);
    *(uint4*)(p.wat + (ln * 64 + e) * 64 + dc * 8) = u;
    u.x = pack2(vx[0], vx[1]); u.y = pack2(vx[2], vx[3]); u.z = pack2(vx[4], vx[5]); u.w = pack2(vx[6], vx[7]);
    *(uint4*)(p.wxt + (ln * 64 + e) * 64 + dc * 8) = u;
  }
  {
    const int lane = threadIdx.x & 63, gw = blockIdx.x * 8 + (threadIdx.x >> 6);
    if (gw < 64) {
      const int lk = gw >> 4, e0 = (gw & 15) * 4;
      float4 acc = make_float4(0.f, 0.f, 0.f, 0.f);
#pragma unroll 8
      for (int i = 0; i < 32; ++i) {
        int k = lane + 64 * i;
        float pz = p.cmp_pos[lk * 2048 + k];
        float4 wv = *(const float4*)(p.cmp_w + ((size_t)lk * 2048 + k) * 64 + e0);
        acc.x += pz * wv.x; acc.y += pz * wv.y; acc.z += pz * wv.z; acc.w += pz * wv.w;
      }
#pragma unroll
      for (int off = 32; off >= 1; off >>= 1) {
        acc.x += __shfl_xor(acc.x, off, 64); acc.y += __shfl_xor(acc.y, off, 64);
        acc.z += __shfl_xor(acc.z, off, 64); acc.w += __shfl_xor(acc.w, off, 64);
      }
      if (lane == 0) *(float4*)(p.cmpbp + gw * 32) = acc;
    }
  }
  for (int i = gtid; i < 4096 * 32; i += gsz) {
    int fi = i & 31, pos = i >> 5;
    float inv = (float)exp(-(double)fi * (9.210340371976184 / 32.0));
    float ang = (float)pos * inv;
    double rev = (double)ang * 0.15915494309189535;
    float fr = (float)(rev - rint(rev));
    float2 cs; cs.x = __builtin_amdgcn_cosf(fr); cs.y = __builtin_amdgcn_sinf(fr);
    ((float2*)p.rot)[i] = cs;
  }
}

template <int MODE>
DI void gemm_tile(const Params& p, int layer, int tm, int tn, char* lds) {
  int tid_ = threadIdx.x; asm volatile("" : "+v"(tid_));
  const int tid = tid_ & 255, lane = tid & 63, w = tid >> 6, l31 = lane & 31, hh = lane >> 5;
  bf16* sA = (bf16*)lds;
  if (tid_ >= 256) {
    const bf16* Ab = p.xb + (size_t)tm * 256 * 1024;
    const bf16* Bb = (MODE == 0 ? p.wint + (size_t)layer * kNP * 1024 : p.woutt + (size_t)layer * 1024 * 1024) + (size_t)tn * 128 * 1024;
    const int lrow = tid >> 3, lcc = tid & 7;
    const bf16* Ap = Ab + lrow * 1024 + lcc * 8;
    const bf16* Bp = Bb + lrow * 1024 + lcc * 8;
    uint4 Pa0, Pa1, Pa2, Pa3, Pa4, Pa5, Pa6, Pa7, Pb0, Pb1, Pb2, Pb3, Qa0, Qa1, Qa2, Qa3, Qa4, Qa5, Qa6, Qa7, Qb0, Qb1, Qb2, Qb3;
#define G_LOAD(R, kt_) { const bf16* Aq = Ap + (kt_) * 64; const bf16* Bq = Bp + (kt_) * 64; \
    R##a0 = *(const uint4*)(Aq); R##a1 = *(const uint4*)(Aq + 32 * 1024); R##a2 = *(const uint4*)(Aq + 64 * 1024); R##a3 = *(const uint4*)(Aq + 96 * 1024); \
    R##a4 = *(const uint4*)(Aq + 128 * 1024); R##a5 = *(const uint4*)(Aq + 160 * 1024); R##a6 = *(const uint4*)(Aq + 192 * 1024); R##a7 = *(const uint4*)(Aq + 224 * 1024); \
    R##b0 = *(const uint4*)(Bq); R##b1 = *(const uint4*)(Bq + 32 * 1024); R##b2 = *(const uint4*)(Bq + 64 * 1024); R##b3 = *(const uint4*)(Bq + 96 * 1024); }
#define G_STORE(R, buf_) { bf16* sAw = sA + (buf_) * (384 * LDK) + lrow * LDK + lcc * 8; bf16* sBw = sAw + 256 * LDK; \
    *(uint4*)(sAw) = R##a0; *(uint4*)(sAw + 32 * LDK) = R##a1; *(uint4*)(sAw + 64 * LDK) = R##a2; *(uint4*)(sAw + 96 * LDK) = R##a3; \
    *(uint4*)(sAw + 128 * LDK) = R##a4; *(uint4*)(sAw + 160 * LDK) = R##a5; *(uint4*)(sAw + 192 * LDK) = R##a6; *(uint4*)(sAw + 224 * LDK) = R##a7; \
    *(uint4*)(sBw) = R##b0; *(uint4*)(sBw + 32 * LDK) = R##b1; *(uint4*)(sBw + 64 * LDK) = R##b2; *(uint4*)(sBw + 96 * LDK) = R##b3; }
    G_LOAD(P, 0)
    __builtin_amdgcn_sched_barrier(0);
    G_LOAD(Q, 1)
    __builtin_amdgcn_sched_barrier(0);
    G_STORE(P, 0)
    G_LOAD(P, 2)
    __syncthreads();
#pragma unroll 1
    for (int kt = 0; kt < 16; kt += 2) {
      G_STORE(Q, 1)
      G_LOAD(Q, (kt + 3 < 16 ? kt + 3 : 15))
      __syncthreads();
      if (kt + 2 < 16) G_STORE(P, 0)
      G_LOAD(P, (kt + 4 < 16 ? kt + 4 : 15))
      __syncthreads();
    }
#undef G_LOAD
#undef G_STORE
    return;
  }
#define FR_LOAD(F, ks_) { F##b0 = *(const bf16x8*)(cB + (ks_) * 16); F##b1 = *(const bf16x8*)(cB + 32 * LDK + (ks_) * 16); \
      F##a0 = *(const bf16x8*)(cA + (ks_) * 16); F##a1 = *(const bf16x8*)(cA + 32 * LDK + (ks_) * 16); \
      F##a2 = *(const bf16x8*)(cA + 64 * LDK + (ks_) * 16); F##a3 = *(const bf16x8*)(cA + 96 * LDK + (ks_) * 16); }
#define FR_MMA(F) { if (MODE == 1) { \
      acc[0][0] = MFMA32(F##a0, F##b0, acc[0][0]); acc[0][1] = MFMA32(F##a0, F##b1, acc[0][1]); \
      acc[1][0] = MFMA32(F##a1, F##b0, acc[1][0]); acc[1][1] = MFMA32(F##a1, F##b1, acc[1][1]); \
      acc[2][0] = MFMA32(F##a2, F##b0, acc[2][0]); acc[2][1] = MFMA32(F##a2, F##b1, acc[2][1]); \
      acc[3][0] = MFMA32(F##a3, F##b0, acc[3][0]); acc[3][1] = MFMA32(F##a3, F##b1, acc[3][1]); \
    } else {     \
      acc[0][0] = MFMA32(F##b0, F##a0, acc[0][0]); acc[0][1] = MFMA32(F##b1, F##a0, acc[0][1]); \
      acc[1][0] = MFMA32(F##b0, F##a1, acc[1][0]); acc[1][1] = MFMA32(F##b1, F##a1, acc[1][1]); \
      acc[2][0] = MFMA32(F##b0, F##a2, acc[2][0]); acc[2][1] = MFMA32(F##b1, F##a2, acc[2][1]); \
      acc[3][0] = MFMA32(F##b0, F##a3, acc[3][0]); acc[3][1] = MFMA32(F##b1, F##a3, acc[3][1]); } }
  f32x16 acc[4][2];
#pragma unroll
  for (int mi = 0; mi < 4; ++mi) { acc[mi][0] = zero16(); acc[mi][1] = zero16(); }
  const int wm = w >> 1, wn = w & 1;
  __syncthreads();
#pragma unroll 1
  for (int kt = 0; kt < 16; ++kt) {
    const bf16* cA = sA + (kt & 1) * (384 * LDK) + (wm * 128 + l31) * LDK + hh * 8;
    const bf16* cB = sA + (kt & 1) * (384 * LDK) + (256 + wn * 64 + l31) * LDK + hh * 8;
    bf16x8 Xa0, Xa1, Xa2, Xa3, Xb0, Xb1, Ya0, Ya1, Ya2, Ya3, Yb0, Yb1;
    FR_LOAD(X, 0)
    FR_LOAD(Y, 1) __builtin_amdgcn_sched_barrier(0); FR_MMA(X) __builtin_amdgcn_sched_barrier(0);
    FR_LOAD(X, 2) __builtin_amdgcn_sched_barrier(0); FR_MMA(Y) __builtin_amdgcn_sched_barrier(0);
    FR_LOAD(Y, 3) __builtin_amdgcn_sched_barrier(0); FR_MMA(X) __builtin_amdgcn_sched_barrier(0);
    FR_MMA(Y)
    __syncthreads();
  }
#undef FR_LOAD
#undef FR_MMA
  const int m0 = tm * 256 + wm * 128, n0 = tn * 128 + wn * 64;
  if (MODE == 1) {
    const float* res = layer == 0 ? p.x : p.out;
    const float alpha = 1.41421356237f;
#pragma unroll
    for (int mi = 0; mi < 4; ++mi)
#pragma unroll
      for (int ni = 0; ni < 2; ++ni) {
        float rv[16];
#pragma unroll
        for (int i = 0; i < 16; ++i)
          rv[i] = res[(size_t)(m0 + mi * 32 + crow(i, hh)) * 1024 + n0 + ni * 32 + l31];
#pragma unroll
        for (int i = 0; i < 16; ++i)
          p.out[(size_t)(m0 + mi * 32 + crow(i, hh)) * 1024 + n0 + ni * 32 + l31] = alpha * rv[i] + acc[mi][ni][i];
      }
    return;
  }
  const int seg = n0 >> 6;
  const bool is_rot = seg < 8;
  const float scale = (seg >= 4 && seg < 8) ? 0.125f : ((seg >= 16 && seg < 24) ? 0.125f * 1.4426950408889634f : 1.f);
  bf16* tdst = nullptr; int hd = 0, nh = 1; float lg2g = 0.f;
  if (seg >= 4 && seg < 8) { tdst = p.kdt; hd = seg - 4; nh = 4; lg2g = log2f(1.f - exp2f(-5.f - (float)hd)); }
  else if (seg >= 8 && seg < 12) { tdst = p.vrt; hd = seg - 8; nh = 4; }
  else if (seg == 30 || seg == 31) { tdst = p.vst; hd = seg - 30; nh = 2; }
  else if (seg == 34 || seg == 35) { tdst = p.vwt; hd = seg - 34; nh = 2; }
  const bool natural = !((seg >= 8 && seg < 12) || seg == 30 || seg == 31 || seg == 34 || seg == 35);
#pragma unroll
  for (int mi = 0; mi < 4; ++mi) {
    const int row = m0 + mi * 32 + l31;
    const int bb = row >> 12, sq = row & 4095;
    if (is_rot) {
#pragma unroll
      for (int g4 = 0; g4 < 4; ++g4) {
        const float4* rp = (const float4*)(p.rot + ((size_t)sq * 32 + 8 * g4 + 4 * hh) * 2);
        float4 c01 = rp[0], c23 = rp[1];
        float cs[4] = {c01.x, c01.z, c23.x, c23.z}, sn[4] = {c01.y, c01.w, c23.y, c23.w};
#pragma unroll
        for (int j = 0; j < 4; ++j) {
          float v0 = acc[mi][0][g4 * 4 + j], v1 = acc[mi][1][g4 * 4 + j];
          acc[mi][0][g4 * 4 + j] = v0 * cs[j] - v1 * sn[j];
          acc[mi][1][g4 * 4 + j] = v0 * sn[j] + v1 * cs[j];
        }
      }
    }
    if (scale != 1.f) {
#pragma unroll
      for (int i = 0; i < 16; ++i) { acc[mi][0][i] *= scale; acc[mi][1][i] *= scale; }
    }
    if (natural) {
#pragma unroll
      for (int ni = 0; ni < 2; ++ni)
#pragma unroll
        for (int g4 = 0; g4 < 4; ++g4) {
          uint2 u; u.x = pack2(acc[mi][ni][g4 * 4 + 0], acc[mi][ni][g4 * 4 + 1]); u.y = pack2(acc[mi][ni][g4 * 4 + 2], acc[mi][ni][g4 * 4 + 3]);
          *(uint2*)(p.proj + (size_t)row * kNP + n0 + ni * 32 + 8 * g4 + 4 * hh) = u;
        }
    }
    if (tdst) {
      const float kd = (lg2g != 0.f) ? exp2f((float)(127 - (sq & 127)) * lg2g) : 1.f;
      bf16* tb = tdst + ((size_t)(bb * nh + hd) * 64) * 4096 + sq;
#pragma unroll
      for (int ni = 0; ni < 2; ++ni)
#pragma unroll
        for (int i = 0; i < 16; ++i)
          tb[(size_t)(ni * 32 + crow(i, hh)) * 4096] = f2bf(acc[mi][ni][i] * kd);
    }
  }
}

DI void ret_kv_unit(const Params& p, int u0) {
  int tid_ = threadIdx.x; asm volatile("" : "+v"(tid_));
  const int u = u0 + 256 * (tid_ >> 8);
  const int tid = tid_ & 255, lane = tid & 63, w = tid >> 6, l31 = lane & 31, hh = lane >> 5;
  const int bh = u >> 5, n = u & 31;
  const int mi = w >> 1, ni = w & 1;
  const bf16* ka = p.kdt + ((size_t)bh * 64 + mi * 32 + l31) * 4096 + n * 128 + hh * 8;
  const bf16* vb = p.vrt + ((size_t)bh * 64 + ni * 32 + l31) * 4096 + n * 128 + hh * 8;
  f32x16 acc = zero16();
#pragma unroll
  for (int ks = 0; ks < 8; ++ks) {
    bf16x8 a = *(const bf16x8*)(ka + ks * 16);
    bf16x8 b = *(const bf16x8*)(vb + ks * 16);
    acc = MFMA32(a, b, acc);
  }
#pragma unroll
  for (int i = 0; i < 16; ++i)
    p.kvc[(size_t)u * 4096 + (mi * 32 + crow(i, hh)) * 64 + ni * 32 + l31] = acc[i];
}

DI void nsa_cmp_unit(const Params& p, int layer, int u, char* lds) {
  if (threadIdx.x >= 256) {
    for (int i_ = 0; i_ < 2; ++i_) __syncthreads();
    return;
  }
  int tid_ = threadIdx.x; asm volatile("" : "+v"(tid_));
  const int tid = tid_, lane = tid & 63, w = tid >> 6, l31 = lane & 31, hh = lane >> 5;
  const int mb2 = u & 7, kv = (u >> 3) & 1, g = (u >> 4) & 1, b = u >> 5;
  const int mb = mb2 >> 1, mt0 = mb2 & 1;
  float* red = (float*)lds;
  const bf16* brow = p.cmpwt + ((size_t)(layer * 2 + kv) * 64 + l31) * 2048 + hh * 8;
  const float* bp = p.cmpbp + (layer * 2 + kv) * 16 * 32;
#pragma unroll 1
  for (int mt = mt0; mt <= mt0; ++mt) {
    int n = mb * 64 + mt * 32 + l31; int nc = n > 254 ? 254 : n;
    const bf16* arow = p.proj + ((size_t)(b * 4096 + 16 * nc)) * kNP + (kv ? C_NVC : C_NKC) + g * 64 + hh * 8;
    f32x16 acc0 = zero16(), acc1 = zero16();
#pragma unroll 4
    for (int lt = w * 8; lt < w * 8 + 8; ++lt) {
#pragma unroll
      for (int ks = 0; ks < 4; ++ks) {
        bf16x8 a = *(const bf16x8*)(arow + (size_t)lt * kNP + ks * 16);
        bf16x8 b0 = *(const bf16x8*)(brow + lt * 64 + ks * 16);
        bf16x8 b1 = *(const bf16x8*)(brow + 32 * 2048 + lt * 64 + ks * 16);
        acc0 = MFMA32(a, b0, acc0);
        acc1 = MFMA32(a, b1, acc1);
      }
    }
    __syncthreads();
#pragma unroll
    for (int i = 0; i < 16; ++i) {
      red[(w * 32 + crow(i, hh)) * 64 + l31] = acc0[i];
      red[(w * 32 + crow(i, hh)) * 64 + 32 + l31] = acc1[i];
    }
    __syncthreads();
    if (kv == 0) {
      for (int idx = tid; idx < 2048; idx += 256) {
        int e = idx & 63, r = idx >> 6;
        float sv = red[idx] + red[2048 + idx] + red[4096 + idx] + red[6144 + idx] + bp[(e >> 2) * 32 + (e & 3)];
        int nn = mb * 64 + mt * 32 + r;
        if (nn > 254) sv = 0.f;
        p.kc[((size_t)(b * 2 + g) * 256 + nn) * 64 + e] = f2bf(sv);
      }
    } else {
      for (int idx = tid; idx < 2048; idx += 256) {
        int r = idx & 31, e = idx >> 5;
        int ridx = r * 64 + e;
        float sv = red[ridx] + red[2048 + ridx] + red[4096 + ridx] + red[6144 + ridx] + bp[(e >> 2) * 32 + (e & 3)];
        int nn = mb * 64 + mt * 32 + r;
        if (nn > 254) sv = 0.f;
        p.vct[((size_t)(b * 2 + g) * 64 + e) * 256 + nn] = f2bf(sv);
      }
    }
  }
}

DI void lru_local_unit(const Params& p, int layer, int u, char* lds) {
  if (threadIdx.x >= 256) {
    for (int i_ = 0; i_ < 12; ++i_) __syncthreads();
    return;
  }
  int tid_ = threadIdx.x; asm volatile("" : "+v"(tid_));
  const int tid = tid_, lane = tid & 63, w = tid >> 6, l31 = lane & 31, hh = lane >> 5;
  const int half = u & 1, chunk = (u >> 1) & 31, b = u >> 6;
  bf16* xcb = (bf16*)lds;
  float* bufA = (float*)(lds + 32 * LDV * 2);
  float* bufU = bufA + 32 * 128;
  const int cl = tid & 127, tg = tid >> 7, chc = half * 128 + cl;
  const float cw0 = p.conv_w[(layer * 4 + 0) * 256 + chc], cw1 = p.conv_w[(layer * 4 + 1) * 256 + chc];
  const float cw2 = p.conv_w[(layer * 4 + 2) * 256 + chc], cw3 = p.conv_w[(layer * 4 + 3) * 256 + chc];
  const float cb = p.conv_b[layer * 256 + chc];
  const bf16* lx = p.proj + (size_t)(b * 4096) * kNP + C_LX + chc;
  const int nbl = w >> 1, ni = w & 1;
  const int nb = half * 2 + nbl;
  const bf16* wa = p.wat + ((size_t)(layer * 4 + nb) * 64 + ni * 32 + l31) * 64 + hh * 8;
  const bf16* wx = p.wxt + ((size_t)(layer * 4 + nb) * 64 + ni * 32 + l31) * 64 + hh * 8;
  const int chl = nbl * 64 + ni * 32 + l31, ch = half * 128 + chl;
  const float ba = p.b_a[layer * 256 + ch], bx = p.b_x[layer * 256 + ch];
  const float sp = log1pf(expf(-p.lam[layer * 256 + ch]));
  float hs = 0.f, As = 1.f;
  float xv[19];
  {
    const int s0 = chunk * 128 + tg * 16;
#pragma unroll
    for (int t = 0; t < 19; ++t) { int sidx = s0 - 3 + t; xv[t] = sidx >= 0 ? bf2f(lx[(size_t)sidx * kNP]) : 0.f; }
  }
#pragma unroll 1
  for (int sc = 0; sc < 4; ++sc) {
    __syncthreads();
    {
#pragma unroll
      for (int t = 0; t < 16; ++t) {
        float xc = xv[t] * cw0 + xv[t + 1] * cw1 + xv[t + 2] * cw2 + xv[t + 3] * cw3 + cb;
        xcb[(tg * 16 + t) * LDV + cl] = f2bf(xc);
        bufU[(tg * 16 + t) * 128 + cl] = xc;
      }
    }
    __syncthreads();
    if (sc < 3) {
      const int s1 = chunk * 128 + (sc + 1) * 32 + tg * 16;
#pragma unroll
      for (int t = 0; t < 19; ++t) xv[t] = bf2f(lx[(size_t)(s1 - 3 + t) * kNP]);
    }
    {
      f32x16 ra = zero16(), rx = zero16();
#pragma unroll
      for (int ks = 0; ks < 4; ++ks) {
        bf16x8 a = *(const bf16x8*)(xcb + l31 * LDV + nbl * 64 + ks * 16 + hh * 8);
        bf16x8 b0 = *(const bf16x8*)(wa + ks * 16);
        bf16x8 b1 = *(const bf16x8*)(wx + ks * 16);
        ra = MFMA32(a, b0, ra);
        rx = MFMA32(a, b1, rx);
      }
#pragma unroll
      for (int i = 0; i < 16; ++i) {
        int t = crow(i, hh);
        float r = sigmoidf_(ra[i] + ba);
        float ig = sigmoidf_(rx[i] + bx);
        float log_a = -8.f * r * sp;
        float a = __expf(log_a);
        float xc = bufU[t * 128 + chl];
        float uu = __builtin_amdgcn_sqrtf(-expm1f(2.f * log_a)) * (ig * xc);
        bufA[t * 128 + chl] = a;
        bufU[t * 128 + chl] = uu;
      }
    }
    __syncthreads();
    if (tid < 128) {
      const size_t tokb = (size_t)b * 4096 + chunk * 128 + sc * 32;
#pragma unroll 8
      for (int t = 0; t < 32; ++t) {
        float a = bufA[t * 128 + tid], uu = bufU[t * 128 + tid];
        hs = a * hs + uu; As *= a;
        p.cuma[(tokb + t) * 256 + chc] = As;
        p.hloc[(tokb + t) * 256 + chc] = hs;
      }
    }
  }
  if (tid < 128) {
    p.suma[(b * 32 + chunk) * 256 + chc] = As;
    p.sumh[(b * 32 + chunk) * 256 + chc] = hs;
  }
}

DI void lru_out_unit(const Params& p, int u) {
  int tid_ = threadIdx.x; asm volatile("" : "+v"(tid_));
  const int tid = tid_;
  const int half = u & 1, chunk = (u >> 1) & 31, b = u >> 6;
  const int cl = tid & 127, tg = tid >> 7, ch = half * 128 + cl;
  float H = 0.f;
  {
    const float* sa = p.suma + (size_t)(b * 32) * 256 + ch;
    const float* sh = p.sumh + (size_t)(b * 32) * 256 + ch;
    int m = 0;
    for (; m + 8 <= chunk; m += 8) {
      float av[8], hv[8];
#pragma unroll
      for (int j = 0; j < 8; ++j) { av[j] = sa[(m + j) * 256]; hv[j] = sh[(m + j) * 256]; }
#pragma unroll
      for (int j = 0; j < 8; ++j) H = av[j] * H + hv[j];
    }
    for (; m < chunk; ++m) H = sa[m * 256] * H + sh[m * 256];
  }
  const size_t tok0 = (size_t)b * 4096 + chunk * 128 + tg * 32;
#pragma unroll 1
  for (int t8 = 0; t8 < 32; t8 += 8) {
    float hv[8], cv[8], gv[8];
#pragma unroll
    for (int j = 0; j < 8; ++j) {
      size_t tok = tok0 + t8 + j;
      hv[j] = p.hloc[tok * 256 + ch]; cv[j] = p.cuma[tok * 256 + ch]; gv[j] = bf2f(p.proj[tok * kNP + C_LG + ch]);
    }
#pragma unroll
    for (int j = 0; j < 8; ++j) {
      size_t tok = tok0 + t8 + j;
      p.xb[tok * 1024 + 768 + ch] = f2bf((hv[j] + cv[j] * H) * siluf_(gv[j]));
    }
  }
}

DI void ret_out_unit(const Params& p, int u0, char* lds0) {
  int tid_ = threadIdx.x; asm volatile("" : "+v"(tid_));
  const int vb = tid_ >> 8;
  const int u = u0 + 256 * vb;
  char* lds = lds0 + vb * 45056;
  const int tid = tid_ & 255, lane = tid & 63, w = tid >> 6, l31 = lane & 31, hh = lane >> 5;
  const int bh = u >> 5, n = u & 31, b = bh >> 2, h = bh & 3;
  bf16* sK = (bf16*)lds;
  bf16* sVt = sK + 128 * LDK;
  bf16* sSt = sVt + 64 * LDV;
  const int tok0 = b * 4096 + n * 128;
  const float lg2g = log2f(1.f - exp2f(-5.f - (float)h));
  __syncthreads();
#pragma unroll
  for (int i = 0; i < 4; ++i) {
    int c = tid + 256 * i;
    { int row = c >> 3, cc = c & 7;
      *(uint4*)(sK + row * LDK + cc * 8) = *(const uint4*)(p.proj + (size_t)(tok0 + row) * kNP + C_RK + h * 64 + cc * 8); }
    { int row = c >> 4, cc = c & 15;
      *(uint4*)(sVt + row * LDV + cc * 8) = *(const uint4*)(p.vrt + ((size_t)bh * 64 + row) * 4096 + n * 128 + cc * 8); }
  }
  {
    const float cd = exp2f(128.f * lg2g);
    float st[16];
#pragma unroll
    for (int j = 0; j < 16; ++j) st[j] = 0.f;
    const float* kvb = p.kvc + (size_t)(bh * 32) * 4096 + tid * 16;
    int m = 0;
    for (; m + 2 <= n; m += 2) {
      const float4* s0 = (const float4*)(kvb + (size_t)m * 4096);
      const float4* s1 = (const float4*)(kvb + (size_t)(m + 1) * 4096);
      float4 a0 = s0[0], a1 = s0[1], a2 = s0[2], a3 = s0[3];
      float4 c0 = s1[0], c1 = s1[1], c2 = s1[2], c3 = s1[3];
      st[0] = (st[0] * cd + a0.x) * cd + c0.x; st[1] = (st[1] * cd + a0.y) * cd + c0.y; st[2] = (st[2] * cd + a0.z) * cd + c0.z; st[3] = (st[3] * cd + a0.w) * cd + c0.w;
      st[4] = (st[4] * cd + a1.x) * cd + c1.x; st[5] = (st[5] * cd + a1.y) * cd + c1.y; st[6] = (st[6] * cd + a1.z) * cd + c1.z; st[7] = (st[7] * cd + a1.w) * cd + c1.w;
      st[8] = (st[8] * cd + a2.x) * cd + c2.x; st[9] = (st[9] * cd + a2.y) * cd + c2.y; st[10] = (st[10] * cd + a2.z) * cd + c2.z; st[11] = (st[11] * cd + a2.w) * cd + c2.w;
      st[12] = (st[12] * cd + a3.x) * cd + c3.x; st[13] = (st[13] * cd + a3.y) * cd + c3.y; st[14] = (st[14] * cd + a3.z) * cd + c3.z; st[15] = (st[15] * cd + a3.w) * cd + c3.w;
    }
    if (m < n) {
      const float4* src = (const float4*)(kvb + (size_t)m * 4096);
      float4 a0 = src[0], a1 = src[1], a2 = src[2], a3 = src[3];
      st[0] = st[0] * cd + a0.x; st[1] = st[1] * cd + a0.y; st[2] = st[2] * cd + a0.z; st[3] = st[3] * cd + a0.w;
      st[4] = st[4] * cd + a1.x; st[5] = st[5] * cd + a1.y; st[6] = st[6] * cd + a1.z; st[7] = st[7] * cd + a1.w;
      st[8] = st[8] * cd + a2.x; st[9] = st[9] * cd + a2.y; st[10] = st[10] * cd + a2.z; st[11] = st[11] * cd + a2.w;
      st[12] = st[12] * cd + a3.x; st[13] = st[13] * cd + a3.y; st[14] = st[14] * cd + a3.z; st[15] = st[15] * cd + a3.w;
    }
    const int d = tid >> 2, e0 = (tid & 3) * 16;
#pragma unroll
    for (int j = 0; j < 16; ++j) sSt[(e0 + j) * LDK + d] = f2bf(st[j]);
  }
  __syncthreads();
  const int qi = w * 32 + l31;
  const size_t tokq = (size_t)tok0 + qi;
  QF qf;
  {
    const bf16* qp = p.proj + tokq * kNP + C_RQ + h * 64 + hh * 8;
    qf.q0 = *(const bf16x8*)(qp); qf.q1 = *(const bf16x8*)(qp + 16); qf.q2 = *(const bf16x8*)(qp + 32); qf.q3 = *(const bf16x8*)(qp + 48);
  }
  f32x16 o[2];
  o[0] = zero16(); o[1] = zero16();
#pragma unroll
  for (int et = 0; et < 2; ++et) {
    const bf16* r = sSt + (et * 32 + l31) * LDK + hh * 8;
    o[et] = MFMA32(*(const bf16x8*)(r), qf.q0, o[et]);
    o[et] = MFMA32(*(const bf16x8*)(r + 16), qf.q1, o[et]);
    o[et] = MFMA32(*(const bf16x8*)(r + 32), qf.q2, o[et]);
    o[et] = MFMA32(*(const bf16x8*)(r + 48), qf.q3, o[et]);
  }
  const float qd = exp2f((float)(qi + 1) * lg2g);
#pragma unroll
  for (int i = 0; i < 16; ++i) { o[0][i] *= qd; o[1][i] *= qd; }
  for (int kt = 0; kt <= w; ++kt) {
    f32x16 s = qk_tile(sK + kt * 32 * LDK, LDK, qf, l31, hh);
#pragma unroll
    for (int i = 0; i < 16; ++i) {
      int key = kt * 32 + crow(i, hh);
      int diff = qi - key;
      s[i] = diff >= 0 ? s[i] * __builtin_amdgcn_exp2f((float)diff * lg2g) : 0.f;
    }
    bf16x8 p0 = pack_half(s, 0), p1 = pack_half(s, 1);
    pv_tile(o, sVt + kt * 32, LDV, p0, p1, l31, hh);
  }
  float s1 = 0.f;
#pragma unroll
  for (int i = 0; i < 16; ++i) s1 += o[0][i] + o[1][i];
  s1 = rsum32(s1);
  const float mean = s1 * (1.f / 64.f);
  float s2 = 0.f;
#pragma unroll
  for (int i = 0; i < 16; ++i) { float a = o[0][i] - mean, c = o[1][i] - mean; s2 += a * a + c * c; }
  s2 = rsum32(s2);
  const float rstd = rsqrtf(s2 * (1.f / 64.f) + 1e-5f);
  uint2 grv[2][4];
#pragma unroll
  for (int et = 0; et < 2; ++et)
#pragma unroll
    for (int g4 = 0; g4 < 4; ++g4) grv[et][g4] = *(const uint2*)(p.proj + tokq * kNP + C_RG + h * 64 + et * 32 + 8 * g4 + 4 * hh);
#pragma unroll
  for (int et = 0; et < 2; ++et)
#pragma unroll
    for (int g4 = 0; g4 < 4; ++g4) {
      int e = et * 32 + 8 * g4 + 4 * hh;
      uint2 gr = grv[et][g4];
      float g0 = __uint_as_float(gr.x << 16), g1 = __uint_as_float(gr.x & 0xffff0000u);
      float g2 = __uint_as_float(gr.y << 16), g3 = __uint_as_float(gr.y & 0xffff0000u);
      float y0 = (o[et][g4 * 4 + 0] - mean) * rstd * siluf_(g0);
      float y1 = (o[et][g4 * 4 + 1] - mean) * rstd * siluf_(g1);
      float y2 = (o[et][g4 * 4 + 2] - mean) * rstd * siluf_(g2);
      float y3 = (o[et][g4 * 4 + 3] - mean) * rstd * siluf_(g3);
      uint2 uo; uo.x = pack2(y0, y1); uo.y = pack2(y2, y3);
      *(uint2*)(p.xb + tokq * 1024 + h * 64 + e) = uo;
    }
}

#define KV_LOAD(kptr_, vptr_) { const bf16* kp_ = (kptr_); const bf16* vp_ = (vptr_); \
    rk0 = *(const uint4*)(kp_ + (size_t)lrow * kstride + lcc * 8); rk1 = *(const uint4*)(kp_ + (size_t)(lrow + 32) * kstride + lcc * 8); \
    rv0 = *(const uint4*)(vp_ + (size_t)lrow * vstride + lcc * 8); rv1 = *(const uint4*)(vp_ + (size_t)(lrow + 32) * vstride + lcc * 8); }

template <int MODE>
DI void nsa_branch(const bf16* kbase, int kstride, const bf16* vbase, int vstride, int jb_lo, int jb_hi, int full_lo, int full_hi,
                   bf16* sK0, bf16* sVt_unused, const QF& qf, int t, int nmax, unsigned sel_lo, unsigned sel_hi,
                   float& m, float& l, f32x16* o, float* imp_row, int tid, int l31, int hh, bool pre, uint4 pk, uint4 pv) {
  const int lrow = tid >> 3, lcc = tid & 7;
  uint4 rk0, rv0;
#define KV_LOAD8(kptr_, vptr_) { rk0 = *(const uint4*)((kptr_) + (size_t)lrow * kstride + lcc * 8); rv0 = *(const uint4*)((vptr_) + (size_t)lrow * vstride + lcc * 8); }
  if (pre) { rk0 = pk; rv0 = pv; }
  else KV_LOAD8(kbase + (size_t)jb_lo * 64 * kstride, vbase + jb_lo * 64)
  float inv_l = 0.f, carry = 0.f;
  if (MODE == 1) inv_l = l > 0.f ? 1.f / l : 0.f;
  __syncthreads();
  *(uint4*)(sK0 + lrow * LDK + lcc * 8) = rk0;
  *(uint4*)(sK0 + 64 * LDK + lrow * LDK + lcc * 8) = rv0;
  if (jb_lo < jb_hi) KV_LOAD8(kbase + (size_t)(jb_lo + 1) * 64 * kstride, vbase + (jb_lo + 1) * 64)
  __syncthreads();
#pragma unroll 1
  for (int jb = jb_lo; jb <= jb_hi; ++jb) {
    const int cur = (jb - jb_lo) & 1;
    const bf16* sK = sK0 + cur * (128 * LDK);
    const bf16* sVt = sK + 64 * LDK;
    if (jb < jb_hi) {
      bf16* dK = sK0 + (cur ^ 1) * (128 * LDK);
      *(uint4*)(dK + lrow * LDK + lcc * 8) = rk0;
      *(uint4*)(dK + 64 * LDK + lrow * LDK + lcc * 8) = rv0;
    }
    if (jb + 1 < jb_hi) KV_LOAD8(kbase + (size_t)(jb + 2) * 64 * kstride, vbase + (jb + 2) * 64)
    const bool full = (jb >= full_lo) && (jb <= full_hi);
    f32x16 s0 = qk_tile(sK, LDK, qf, l31, hh);
    f32x16 s1 = qk_tile(sK + 32 * LDK, LDK, qf, l31, hh);
    bool selb = true;
    if (MODE == 2) selb = ((jb < 32 ? sel_lo >> jb : sel_hi >> (jb - 32)) & 1u) != 0;
    if (!full) {
#pragma unroll
      for (int i = 0; i < 16; ++i) {
        const int key = jb * 64 + crow(i, hh);
        bool v0, v1;
        if (MODE <= 1) { v0 = key <= nmax; v1 = key + 32 <= nmax; }
        else if (MODE == 2) { v0 = selb && key <= t; v1 = selb && key + 32 <= t; }
        else { v0 = key <= t && key > t - 512; v1 = key + 32 <= t && key + 32 > t - 512; }
        s0[i] = v0 ? s0[i] : -1e30f;
        s1[i] = v1 ? s1[i] : -1e30f;
      }
    }
    if (MODE == 1) {
#pragma unroll
      for (int i = 0; i < 16; ++i) {
        float a0 = s0[i], a1 = s1[i];
        float p0 = __builtin_amdgcn_exp2f(a0 - m) * inv_l, p1 = __builtin_amdgcn_exp2f(a1 - m) * inv_l;
        s0[i] = (full || a0 > -1e29f) ? p0 : 0.f;
        s1[i] = (full || a1 > -1e29f) ? p1 : 0.f;
      }
#pragma unroll
      for (int sub = 0; sub < 2; ++sub) {
        const f32x16& pp = sub ? s1 : s0;
        float e0 = xor32x(pp[3], hh), e1 = xor32x(pp[7], hh), e2 = xor32x(pp[11], hh), e3 = xor32x(pp[15], hh);
        float r0 = hh ? e0 : carry, r1 = hh ? e1 : e0, r2 = hh ? e2 : e1, r3 = hh ? e3 : e2;
        carry = e3;
        float* dst = imp_row + ((jb * 64 + sub * 32) >> 2) + hh;
        dst[0] = 2.f * (pp[0] + pp[1] + pp[2]) + pp[3] + r0;
        dst[2] = 2.f * (pp[4] + pp[5] + pp[6]) + pp[7] + r1;
        dst[4] = 2.f * (pp[8] + pp[9] + pp[10]) + pp[11] + r2;
        dst[6] = 2.f * (pp[12] + pp[13] + pp[14]) + pp[15] + r3;
      }
    } else {
      float mx = -1e30f;
#pragma unroll
      for (int i = 0; i < 16; ++i) mx = max3f(mx, s0[i], s1[i]);
      mx = rmax32(mx);
      if (MODE == 2 && full) mx = selb ? mx : -1e30f;
      if (__any(mx > m + 8.f)) {
        const float m_new = fmaxf(m, mx);
        const float alpha = __builtin_amdgcn_exp2f(m - m_new);
        l *= alpha; m = m_new;
        if (MODE >= 2) {
#pragma unroll
          for (int i = 0; i < 16; ++i) { o[0][i] *= alpha; o[1][i] *= alpha; }
        }
      }
      const float msub = (MODE == 2 && full && !selb) ? 1e30f : m;
      const fl2_t m2 = {msub, msub};
      fl2_t rs2 = {0.f, 0.f};
#pragma unroll
      for (int i = 0; i < 16; i += 2) {
        fl2_t a = {s0[i], s0[i + 1]}, c = {s1[i], s1[i + 1]};
        fl2_t da = a - m2, dc = c - m2;
        fl2_t pa = {__builtin_amdgcn_exp2f(da.x), __builtin_amdgcn_exp2f(da.y)};
        fl2_t pc = {__builtin_amdgcn_exp2f(dc.x), __builtin_amdgcn_exp2f(dc.y)};
        if (!full) {
          pa.x = a.x > -1e29f ? pa.x : 0.f; pa.y = a.y > -1e29f ? pa.y : 0.f;
          pc.x = c.x > -1e29f ? pc.x : 0.f; pc.y = c.y > -1e29f ? pc.y : 0.f;
        }
        s0[i] = pa.x; s0[i + 1] = pa.y; s1[i] = pc.x; s1[i + 1] = pc.y;
        rs2 += pa; rs2 += pc;
      }
      l += rsum32(rs2.x + rs2.y);
    }
    if (MODE >= 1) {
      pv_tile(o, sVt, LDK, pack_half(s0, 0), pack_half(s0, 1), l31, hh);
      pv_tile(o, sVt + 32, LDK, pack_half(s1, 0), pack_half(s1, 1), l31, hh);
    }
    __syncthreads();
  }
#undef KV_LOAD8
}

DI void nsa_unit(const Params& p, int u, char* lds) {
  int tid_ = threadIdx.x; asm volatile("" : "+v"(tid_));
  const int tid = tid_, lane = tid & 63, w = tid >> 6, l31 = lane & 31, hh = lane >> 5;
  const int hw = w & 3, qs = w >> 2;
  const int qt = (u < 256) ? 63 - (u >> 3) : ((u - 256) >> 3), bg = u & 7, b = bg >> 1, g = bg & 1;
  const int t0 = qt * 64, t = t0 + qs * 32 + l31, c64 = t0 >> 6;
  const size_t tok = (size_t)b * 4096 + t;
  bf16* sK = (bf16*)lds;
  bf16* sVt = sK + 64 * LDK;
  float* imp = (float*)(lds + 4 * 64 * LDK * 2);
  unsigned* selm = (unsigned*)(imp + 4 * 64 * 64);
  const int head = g * 4 + hw;
  QF qf;
  {
    const bf16* qp = p.proj + tok * kNP + C_NQ + head * 64 + hh * 8;
    qf.q0 = *(const bf16x8*)(qp); qf.q1 = *(const bf16x8*)(qp + 16); qf.q2 = *(const bf16x8*)(qp + 32); qf.q3 = *(const bf16x8*)(qp + 48);
  }
  float gc, gs, gw;
  {
    const bf16* gp = p.proj + tok * kNP + C_NGL + head * 3;
    gc = sigmoidf_(bf2f(gp[0])); gs = sigmoidf_(bf2f(gp[1])); gw = sigmoidf_(bf2f(gp[2]));
  }
  f32x16 o[2];
  float m, l;
  const int nmax = (t - 31) >> 4;
  const int ncmp_tiles = (t0 / 16 + 3 + 63) >> 6;
  const int cfull_hi = ((((t0 - 31) >> 4) - 63) >> 6);
  const bf16* kcb = p.kc + (size_t)(b * 2 + g) * 256 * 64;
  const bf16* vcb = p.vct + (size_t)(b * 2 + g) * 64 * 256;
  float* imp_row = imp + hw * 4096 + (qs * 32 + l31) * 64;
  m = -1e30f; l = 0.f;
  const int lrow = tid >> 3, lcc = tid & 7;
  uint4 c2k = *(const uint4*)(kcb + (size_t)lrow * 64 + lcc * 8), c2v = *(const uint4*)(vcb + (size_t)lrow * 256 + lcc * 8);
  nsa_branch<0>(kcb, 64, vcb, 256, 0, ncmp_tiles - 1, 0, cfull_hi, sK, sVt, qf, t, nmax, 0u, 0u, m, l, o, nullptr, tid, l31, hh, false, c2k, c2v);
  o[0] = zero16(); o[1] = zero16();
  nsa_branch<1>(kcb, 64, vcb, 256, 0, ncmp_tiles - 1, 0, cfull_hi, sK, sVt, qf, t, nmax, 0u, 0u, m, l, o, imp_row, tid, l31, hh, true, c2k, c2v);
  __syncthreads();
  const bf16* kb_s = p.proj + (size_t)b * 4096 * kNP + C_NKS + g * 64;
  const bf16* vb_s = p.vst + (size_t)(b * 2 + g) * 64 * 4096;
  const bf16* kb_w = p.proj + (size_t)b * 4096 * kNP + C_NKW + g * 64;
  const bf16* vb_w = p.vwt + (size_t)(b * 2 + g) * 64 * 4096;
  const int jlo_w = c64 - 8 < 0 ? 0 : c64 - 8;
  const uint4 sk0 = *(const uint4*)(kb_s + (size_t)lrow * kNP + lcc * 8), sv0 = *(const uint4*)(vb_s + (size_t)lrow * 4096 + lcc * 8);
  const uint4 wk0 = *(const uint4*)(kb_w + (size_t)(jlo_w * 64 + lrow) * kNP + lcc * 8), wv0 = *(const uint4*)(vb_w + (size_t)lrow * 4096 + jlo_w * 64 + lcc * 8);
#pragma unroll 1
  for (int qi = 0; qi < 8; ++qi) {
    const int q = w * 8 + qi, j = lane;
    float v = imp[(0 * 64 + q) * 64 + j] + imp[(1 * 64 + q) * 64 + j] + imp[(2 * 64 + q) * 64 + j] + imp[(3 * 64 + q) * 64 + j];
    const bool causal = j <= c64;
    const bool forced = (j == 0) | (j == c64) | (j == c64 - 1);
    v = forced ? 1.0e4f : (causal ? v : 0.f);
    const unsigned key = causal ? ((__float_as_uint(v) & ~63u) | (unsigned)(63 - j)) : 0u;
    int rank = 0;
#pragma unroll
    for (int i = 0; i < 64; ++i) {
      unsigned ki = __builtin_amdgcn_readlane(key, i);
      rank += (ki > key) ? 1 : 0;
    }
    const bool sel = (rank < 16) & causal;
    unsigned long long mk = __ballot(sel);
    if (lane == 0) { selm[q * 2] = (unsigned)mk; selm[q * 2 + 1] = (unsigned)(mk >> 32); }
  }
  __syncthreads();
  const unsigned sel_lo = selm[(qs * 32 + l31) * 2], sel_hi = selm[(qs * 32 + l31) * 2 + 1];
  float* rs_ = imp + w * 2048 + lane;
#pragma unroll
  for (int et = 0; et < 2; ++et)
#pragma unroll
    for (int i = 0; i < 16; ++i) rs_[(et * 16 + i) * 64] = gc * o[et][i];
  {
    m = -1e30f; l = 0.f; o[0] = zero16(); o[1] = zero16();
    const bf16* kb = p.proj + (size_t)b * 4096 * kNP + C_NKS + g * 64;
    const bf16* vb = p.vst + (size_t)(b * 2 + g) * 64 * 4096;
    nsa_branch<2>(kb, kNP, vb, 4096, 0, c64, 0, c64 - 1, sK, sVt, qf, t, 0, sel_lo, sel_hi, m, l, o, nullptr, tid, l31, hh, true, sk0, sv0);
    const float sc = gs / l;
#pragma unroll
    for (int et = 0; et < 2; ++et)
#pragma unroll
      for (int i = 0; i < 16; ++i) rs_[(et * 16 + i) * 64] += sc * o[et][i];
  }
  {
    m = -1e30f; l = 0.f; o[0] = zero16(); o[1] = zero16();
    const bf16* kb = p.proj + (size_t)b * 4096 * kNP + C_NKW + g * 64;
    const bf16* vb = p.vwt + (size_t)(b * 2 + g) * 64 * 4096;
    const int jlo = c64 - 8 < 0 ? 0 : c64 - 8;
    const int flo = c64 - 7 < 0 ? 0 : c64 - 7;
    nsa_branch<3>(kb, kNP, vb, 4096, jlo, c64, flo, c64 - 1, sK, sVt, qf, t, 0, 0u, 0u, m, l, o, nullptr, tid, l31, hh, true, wk0, wv0);
    const float sc = gw / l;
#pragma unroll
    for (int et = 0; et < 2; ++et)
#pragma unroll
      for (int i = 0; i < 16; ++i) o[et][i] = rs_[(et * 16 + i) * 64] + sc * o[et][i];
  }
  uint2 grv[2][4];
#pragma unroll
  for (int et = 0; et < 2; ++et)
#pragma unroll
    for (int g4 = 0; g4 < 4; ++g4)
      grv[et][g4] = *(const uint2*)(p.proj + tok * kNP + C_NG + head * 64 + et * 32 + 8 * g4 + 4 * hh);
#pragma unroll
  for (int et = 0; et < 2; ++et)
#pragma unroll
    for (int g4 = 0; g4 < 4; ++g4) {
      const int e = et * 32 + 8 * g4 + 4 * hh;
      uint2 gr = grv[et][g4];
      float g0 = __uint_as_float(gr.x << 16), g1 = __uint_as_float(gr.x & 0xffff0000u);
      float g2 = __uint_as_float(gr.y << 16), g3 = __uint_as_float(gr.y & 0xffff0000u);
      uint2 uo;
      uo.x = pack2(o[et][g4 * 4 + 0] * siluf_(g0), o[et][g4 * 4 + 1] * siluf_(g1));
      uo.y = pack2(o[et][g4 * 4 + 2] * siluf_(g2), o[et][g4 * 4 + 3] * siluf_(g3));
      *(uint2*)(p.xb + tok * 1024 + 256 + head * 64 + e) = uo;
    }
}

DI void ln_phase(const Params& p, int layer) {
  int tid_ = threadIdx.x; asm volatile("" : "+v"(tid_));
  const int lane = tid_ & 63, w = tid_ >> 6;
  float4 ggv[4], bbv[4];
#pragma unroll
  for (int i = 0; i < 4; ++i) {
    ggv[i] = *(const float4*)(p.ln_g + layer * 1024 + (i * 64 + lane) * 4);
    bbv[i] = *(const float4*)(p.ln_b + layer * 1024 + (i * 64 + lane) * 4);
  }
  const int nwaves = gridDim.x * 8;
  constexpr int R = 4;
  for (int row0 = blockIdx.x * 8 + w; row0 < kT; row0 += R * nwaves) {
    float4 v[R][4];
    float sm[R], q[R], mean[R];
#pragma unroll
    for (int r = 0; r < R; ++r) {
      int row = row0 + r * nwaves; if (row >= kT) row = row0;
      sm[r] = 0.f;
#pragma unroll
      for (int i = 0; i < 4; ++i) {
        v[r][i] = *(const float4*)(p.out + (size_t)row * 1024 + (i * 64 + lane) * 4);
        sm[r] += v[r][i].x + v[r][i].y + v[r][i].z + v[r][i].w;
      }
    }
#pragma unroll
    for (int off = 32; off >= 1; off >>= 1) {
#pragma unroll
      for (int r = 0; r < R; ++r) sm[r] += __shfl_xor(sm[r], off, 64);
    }
#pragma unroll
    for (int r = 0; r < R; ++r) {
      mean[r] = sm[r] * (1.f / 1024.f); q[r] = 0.f;
#pragma unroll
      for (int i = 0; i < 4; ++i) {
        float a = v[r][i].x - mean[r], b = v[r][i].y - mean[r], c = v[r][i].z - mean[r], d = v[r][i].w - mean[r];
        q[r] += a * a + b * b + c * c + d * d;
      }
    }
#pragma unroll
    for (int off = 32; off >= 1; off >>= 1) {
#pragma unroll
      for (int r = 0; r < R; ++r) q[r] += __shfl_xor(q[r], off, 64);
    }
#pragma unroll
    for (int r = 0; r < R; ++r) {
      const int row = row0 + r * nwaves;
      if (row < kT) {
        const float rstd = rsqrtf(q[r] * (1.f / 1024.f) + 1e-5f);
#pragma unroll
        for (int i = 0; i < 4; ++i) {
          int col = (i * 64 + lane) * 4;
          float4 gg = ggv[i], bb = bbv[i];
          float4 y;
          y.x = (v[r][i].x - mean[r]) * rstd * gg.x + bb.x; y.y = (v[r][i].y - mean[r]) * rstd * gg.y + bb.y;
          y.z = (v[r][i].z - mean[r]) * rstd * gg.z + bb.z; y.w = (v[r][i].w - mean[r]) * rstd * gg.w + bb.w;
          *(float4*)(p.out + (size_t)row * 1024 + col) = y;
          if (layer == 0) {
            uint2 ub; ub.x = pack2(y.x, y.y); ub.y = pack2(y.z, y.w);
            *(uint2*)(p.xb + (size_t)row * 1024 + col) = ub;
          }
        }
      }
    }
  }
}

namespace pg8 {
#define PG8_LAS __attribute__((address_space(3)))
typedef unsigned short bf16_t;
typedef short bf16x8 __attribute__((ext_vector_type(8)));
typedef float f32x4 __attribute__((ext_vector_type(4)));
typedef unsigned u32x4 __attribute__((ext_vector_type(4)));
constexpr int BM = 256, BK = 64, HALF = 128, HTB = HALF * BK * 2  , STAGE_BYTES = 8 * HTB, NXCD = 8, WGM = 8;

__host__ __device__ __forceinline__ int lds_byte(int r, int c) { const int st = (r >> 4) * 2 + (c >> 5), rr = r & 15, cc = c & 31, ob = rr * 64 + cc * 2; return st * 1024 + (ob ^ (((ob >> 9) & 1) << 5)); }
__host__ __device__ __forceinline__ void stage_rc(int b, int& R, int& C) { const int st = b / 1024, sb = b % 1024, swz = sb ^ (((sb >> 9) & 1) << 5); R = (st >> 1) * 16 + swz / 64; C = (st & 1) * 32 + (swz % 64) / 2; }
__host__ __device__ __forceinline__ int perm32(int rho) { const int n = rho >> 4, i = rho & 15; return 8 * (i >> 2) + 4 * n + (i & 3); }

struct Unit { int pm, pn; };
struct Gemm { const bf16_t* A; const bf16_t* Bt; int M, N, K; };

struct StaticOrder {
    int nM, nN, nwg, G, c;
    __host__ __device__ void init(int M, int N, int G_, int c_) { nM = M / BM; nN = N / BM; nwg = nM * nN; G = G_; c = c_; }
    __host__ __device__ bool next(int i, Unit& u) const {
        const long L = (long)i * G + c; if (L >= nwg) return false;
        int wgid = (int)L; { const int q = nwg / NXCD, r = nwg % NXCD, xcd = wgid % NXCD, off = wgid / NXCD; wgid = (xcd < r ? xcd * (q + 1) : r * (q + 1) + (xcd - r) * q) + off; }
        const int nig = WGM * nN, gid = wgid / nig, fm = gid * WGM, gsz = (nM - fm) < WGM ? (nM - fm) : WGM;
        u.pm = fm + ((wgid % nig) % gsz); u.pn = (wgid % nig) / gsz; return true;
    }
    __device__ __forceinline__ void a_ready(const Unit&) const {}
    __device__ __forceinline__ void done(const Unit&) const {}
};
template <class Epi, class Sched, bool STAMP = false>
__device__ __forceinline__ void gemm_phase(PG8_LAS unsigned char* lds, const Gemm g, const Sched& S, const Epi& E, unsigned long long* stamps) {
    int tid_ = threadIdx.x; asm volatile("" : "+v"(tid_));
    const int tid = tid_, wid = __builtin_amdgcn_readfirstlane(tid >> 6), lane = tid & 63, wr = wid >> 2, wc = wid & 3, fr = lane & 15, fq = lane >> 4;
    const int K = g.K, nt = K / BK;
    int ts_lo = 0, ts_hi = 0, nts = 0; const unsigned long long rt_entry = STAMP ? (unsigned long long)wall_clock64() : 0ull;
#define PG8_STAMP() do { if (STAMP && wid == 0 && nts < 64) { const unsigned long long _c = (unsigned long long)clock64(); \
        ts_lo = (lane == nts) ? (int)(unsigned)_c : ts_lo; ts_hi = (lane == nts) ? (int)(unsigned)(_c >> 32) : ts_hi; ++nts; } } while (0)
    PG8_STAMP();
    unsigned voffA[2], voffB[2];
#pragma unroll
    for (int i = 0; i < 2; ++i) { int R, C; stage_rc(tid * 16 + i * 8192, R, C); const int Rb = Epi::PERM ? ((R & ~31) + perm32(R & 31)) : R;
        voffA[i] = (unsigned)(R * K + C) * 2u; voffB[i] = (unsigned)(Rb * K + C) * 2u; }
    const size_t kstep = (size_t)(BK * 2);
    const size_t hstep = (size_t)HALF * K * 2;
    const size_t tstep = 2 * hstep;
    const unsigned ldsw = (unsigned)wid * 1024u;
    const int aoff = lds_byte(wr * 64 + fr, fq * 8), boff = lds_byte(wc * 32 + fr, fq * 8);
#define PG8_SA(b, h) (((b) * 2 + (h)) * HTB)
#define PG8_SB(b, h) ((4 + (b) * 2 + (h)) * HTB)
#define PG8_STAGE(bufoff, gbase, voff) do { _Pragma("unroll") for (int _i = 0; _i < 2; ++_i) \
        __builtin_amdgcn_global_load_lds((const unsigned*)((const char*)(gbase) + (voff)[_i]), (PG8_LAS unsigned*)(lds + (bufoff) + ldsw + _i * 8192), 16, 0, 0); } while (0)
#define PG8_LDA(dst, b, h) do { _Pragma("unroll") for (int m = 0; m < 4; ++m) _Pragma("unroll") for (int k = 0; k < 2; ++k) dst[m][k] = *(const PG8_LAS bf16x8*)(lds + PG8_SA(b, h) + aoff + m * 2048 + k * 1024); } while (0)
#define PG8_LDB(dst, b, h) do { _Pragma("unroll") for (int n = 0; n < 2; ++n) _Pragma("unroll") for (int k = 0; k < 2; ++k) dst[n][k] = *(const PG8_LAS bf16x8*)(lds + PG8_SB(b, h) + boff + n * 2048 + k * 1024); } while (0)
#define PG8_MMA(ai, bj, At, Bt) do { __builtin_amdgcn_s_setprio(1); _Pragma("unroll") for (int m = 0; m < 4; ++m) _Pragma("unroll") for (int n = 0; n < 2; ++n) _Pragma("unroll") for (int k = 0; k < 2; ++k) \
        acc[ai][bj][m][n] = __builtin_amdgcn_mfma_f32_16x16x32_bf16(Bt[n][k], At[m][k], acc[ai][bj][m][n], 0, 0, 0); __builtin_amdgcn_s_setprio(0); } while (0)
#define PG8_WAIT_V(n) asm volatile("s_waitcnt vmcnt(" #n ")" ::: "memory")
#define PG8_WAIT_L(n) asm volatile("s_waitcnt lgkmcnt(" #n ")" ::: "memory")
#define PG8_BAR __builtin_amdgcn_s_barrier()
#define PG8_SCHED __builtin_amdgcn_sched_barrier(0)
    Unit cur, nxt; int ui = 0;
    if (!S.next(0, cur)) return;
    f32x4 acc[2][2][4][2];
#pragma unroll
    for (int a = 0; a < 2; ++a)
#pragma unroll
        for (int b = 0; b < 2; ++b)
#pragma unroll
            for (int m = 0; m < 4; ++m)
#pragma unroll
                for (int n = 0; n < 2; ++n) acc[a][b][m][n] = (f32x4){0.f, 0.f, 0.f, 0.f};
    bf16x8 At[4][2], B0[2][2], B1[2][2];
    const char* cA = (const char*)g.A + (size_t)cur.pm * tstep; const char* cB = (const char*)g.Bt + (size_t)cur.pn * tstep;
    S.a_ready(cur);
    PG8_STAGE(PG8_SB(0, 0), cB, voffB); PG8_STAGE(PG8_SA(0, 0), cA, voffA); PG8_STAGE(PG8_SB(0, 1), cB + hstep, voffB); PG8_STAGE(PG8_SA(0, 1), cA + hstep, voffA);
    if (wr == 1) PG8_BAR;
    PG8_WAIT_V(4); PG8_BAR;
    PG8_STAGE(PG8_SB(1, 0), cB + kstep, voffB); PG8_STAGE(PG8_SA(1, 0), cA + kstep, voffA); PG8_STAGE(PG8_SB(1, 1), cB + hstep + kstep, voffB);
    PG8_WAIT_V(6); PG8_BAR;
    PG8_STAMP();
    for (;;) {
        const bool has_next = S.next(ui + 1, nxt);
        const char* nA = has_next ? (const char*)g.A + (size_t)nxt.pm * tstep : cA; const char* nB = has_next ? (const char*)g.Bt + (size_t)nxt.pn * tstep : cB;
        for (int t = 0; t < nt; t += 2) {
            const bool last = (t == nt - 2);
            const char* a1 = cA + (size_t)(t + 1) * kstep;
            const char* a2 = last ? nA : cA + (size_t)(t + 2) * kstep; const char* b2 = last ? nB : cB + (size_t)(t + 2) * kstep;
            const char* a3 = a2 + kstep; const char* b3 = b2 + kstep;
            if (last && has_next) S.a_ready(nxt);
            PG8_LDB(B0, 0, 0); PG8_SCHED; PG8_LDA(At, 0, 0); PG8_STAGE(PG8_SA(1, 1), a1 + hstep, voffA);
            PG8_WAIT_L(8); PG8_BAR; PG8_WAIT_L(0); PG8_MMA(0, 0, At, B0); PG8_BAR; PG8_SCHED;
            PG8_LDB(B1, 0, 1); PG8_STAGE(PG8_SB(0, 0), b2, voffB);
            PG8_BAR; PG8_WAIT_L(0); PG8_MMA(0, 1, At, B1); PG8_BAR;
            PG8_LDA(At, 0, 1); PG8_STAGE(PG8_SA(0, 0), a2, voffA);
            PG8_BAR; PG8_WAIT_L(0); PG8_MMA(1, 0, At, B0); PG8_BAR; PG8_SCHED;
            PG8_STAGE(PG8_SB(0, 1), b2 + hstep, voffB);
            PG8_WAIT_V(6); PG8_BAR; PG8_MMA(1, 1, At, B1); PG8_BAR;
            PG8_LDB(B0, 1, 0); PG8_SCHED; PG8_LDA(At, 1, 0); PG8_STAGE(PG8_SA(0, 1), a2 + hstep, voffA);
            PG8_WAIT_L(8); PG8_BAR; PG8_WAIT_L(0); PG8_MMA(0, 0, At, B0); PG8_BAR; PG8_SCHED;
            PG8_LDB(B1, 1, 1); PG8_STAGE(PG8_SB(1, 0), b3, voffB);
            PG8_BAR; PG8_WAIT_L(0); PG8_MMA(0, 1, At, B1); PG8_BAR;
            PG8_LDA(At, 1, 1); PG8_STAGE(PG8_SA(1, 0), a3, voffA);
            PG8_BAR; PG8_WAIT_L(0); PG8_MMA(1, 0, At, B0); PG8_BAR; PG8_SCHED;
            PG8_STAGE(PG8_SB(1, 1), b3 + hstep, voffB);
            PG8_WAIT_V(6); PG8_BAR; PG8_MMA(1, 1, At, B1); PG8_BAR;
        }
        PG8_STAMP();
        if constexpr (!Epi::AFTER_DRAIN) { E(acc, cur, wr, wc, fr, fq); S.done(cur); }
        PG8_STAMP();
        if (!has_next) break;
#pragma unroll
        for (int a = 0; a < 2; ++a)
#pragma unroll
            for (int b = 0; b < 2; ++b)
#pragma unroll
                for (int m = 0; m < 4; ++m)
#pragma unroll
                    for (int n = 0; n < 2; ++n) acc[a][b][m][n] = (f32x4){0.f, 0.f, 0.f, 0.f};
        cur = nxt; cA = nA; cB = nB; ++ui;
    }
    PG8_WAIT_V(0);
    if (wr == 0) PG8_BAR;
    PG8_BAR;
    if constexpr (Epi::AFTER_DRAIN) { E.fused(acc, cur, wr, wc, fr, fq, lds, wid, lane); S.done(cur); }
    PG8_STAMP();
    if (STAMP && wid == 0) { stamps[lane] = lane < nts ? (((unsigned long long)(unsigned)ts_hi << 32) | (unsigned)ts_lo) : 0ull;
        if (lane == 62) stamps[62] = rt_entry; if (lane == 63) stamps[63] = (unsigned long long)wall_clock64(); }
#undef PG8_STAMP
#undef PG8_SA
#undef PG8_SB
#undef PG8_STAGE
#undef PG8_LDA
#undef PG8_LDB
#undef PG8_MMA
#undef PG8_WAIT_V
#undef PG8_WAIT_L
#undef PG8_BAR
#undef PG8_SCHED
}
}


struct EpiIn {
  static constexpr bool PERM = false, AFTER_DRAIN = false;
  bf16 *proj, *kdt, *vrt, *vst, *vwt; const float* rot;
  __device__ __forceinline__ void operator()(const pg8::f32x4 (&acc)[2][2][4][2], const pg8::Unit& u, int wr, int wc, int fr, int fq) const {
    const int a = wc & 1, f = 16 * a + 4 * fq;
#pragma unroll
    for (int bj = 0; bj < 2; ++bj) {
      const int seg = u.pn * 4 + bj * 2 + (wc >> 1);
      if (seg >= 54) continue;
      const bool is_rot = seg < 8;
      const float scale = (seg >= 4 && seg < 8) ? 0.125f : ((seg >= 16 && seg < 24) ? 0.125f * 1.4426950408889634f : 1.f);
      bf16* tdst = nullptr; int hd = 0, nh = 1; float lg2g = 0.f;
      if (seg >= 4 && seg < 8) { tdst = kdt; hd = seg - 4; nh = 4; lg2g = log2f(1.f - exp2f(-5.f - (float)hd)); }
      else if (seg >= 8 && seg < 12) { tdst = vrt; hd = seg - 8; nh = 4; }
      else if (seg == 30 || seg == 31) { tdst = vst; hd = seg - 30; nh = 2; }
      else if (seg == 34 || seg == 35) { tdst = vwt; hd = seg - 34; nh = 2; }
      const bool natural = !((seg >= 8 && seg < 12) || seg == 30 || seg == 31 || seg == 34 || seg == 35);
#pragma unroll
      for (int ai = 0; ai < 2; ++ai)
#pragma unroll
        for (int m = 0; m < 4; ++m) {
          const int row = u.pm * 256 + ai * 128 + wr * 64 + m * 16 + fr;
          const int bb = row >> 12, sq = row & 4095;
          pg8::f32x4 v0 = acc[ai][bj][m][0], v1 = acc[ai][bj][m][1];
          if (is_rot) {
            const float4* rp = (const float4*)(rot + ((size_t)sq * 32 + f) * 2);
            float4 c01 = rp[0], c23 = rp[1];
            float cs[4] = {c01.x, c01.z, c23.x, c23.z}, sn[4] = {c01.y, c01.w, c23.y, c23.w};
#pragma unroll
            for (int j = 0; j < 4; ++j) { float x0 = v0[j], x1 = v1[j]; v0[j] = x0 * cs[j] - x1 * sn[j]; v1[j] = x0 * sn[j] + x1 * cs[j]; }
          }
          if (scale != 1.f) { v0 *= scale; v1 *= scale; }
          if (natural) {
            uint2 q0; q0.x = pack2(v0[0], v0[1]); q0.y = pack2(v0[2], v0[3]);
            uint2 q1; q1.x = pack2(v1[0], v1[1]); q1.y = pack2(v1[2], v1[3]);
            bf16* dst = proj + (size_t)row * kNP + seg * 64 + f;
            *(uint2*)(dst) = q0; *(uint2*)(dst + 32) = q1;
          }
          if (tdst) {
            const float kd = (lg2g != 0.f) ? exp2f((float)(127 - (sq & 127)) * lg2g) : 1.f;
            bf16* tb = tdst + ((size_t)(bb * nh + hd) * 64 + f) * 4096 + sq;
#pragma unroll
            for (int j = 0; j < 4; ++j) { tb[(size_t)j * 4096] = f2bf(v0[j] * kd); tb[(size_t)(32 + j) * 4096] = f2bf(v1[j] * kd); }
          }
        }
    }
  }
};
struct EpiOut {
  static constexpr bool PERM = false, AFTER_DRAIN = false;
  const float* res; float* out;
  __device__ __forceinline__ void operator()(const pg8::f32x4 (&acc)[2][2][4][2], const pg8::Unit& u, int wr, int wc, int fr, int fq) const {
    const float alpha = 1.41421356237f;
    const int row0 = u.pm * 256 + wr * 64 + fr, col0 = u.pn * 256 + wc * 32 + 4 * fq;
#pragma unroll
    for (int ai = 0; ai < 2; ++ai)
#pragma unroll
      for (int m = 0; m < 4; ++m) {
        const size_t off = (size_t)(row0 + ai * 128 + m * 16) * 1024 + col0;
        pg8::f32x4 rv[2][2];
#pragma unroll
        for (int bj = 0; bj < 2; ++bj)
#pragma unroll
          for (int n = 0; n < 2; ++n) rv[bj][n] = *(const pg8::f32x4*)(res + off + bj * 128 + n * 16);
#pragma unroll
        for (int bj = 0; bj < 2; ++bj)
#pragma unroll
          for (int n = 0; n < 2; ++n) *(pg8::f32x4*)(out + off + bj * 128 + n * 16) = alpha * rv[bj][n] + acc[ai][bj][m][n];
      }
  }
};

DI unsigned bar_ld(unsigned* q) { return __hip_atomic_load(q, __ATOMIC_RELAXED, __HIP_MEMORY_SCOPE_AGENT); }
DI unsigned bar_add(unsigned* q, unsigned v) { return __hip_atomic_fetch_add(q, v, __ATOMIC_RELAXED, __HIP_MEMORY_SCOPE_AGENT); }
DI unsigned xcc_id() { return (unsigned)__builtin_amdgcn_s_getreg((3 << 11) | 20) & 0xFu; }

DI void grid_barrier(unsigned* ctr, unsigned target) {
  asm volatile("s_waitcnt vmcnt(0)" ::: "memory");
  __syncthreads();
  if (threadIdx.x == 0) {
    __builtin_amdgcn_fence(__ATOMIC_RELEASE, "agent");
    asm volatile("s_waitcnt vmcnt(0)" ::: "memory");
    bar_add(ctr, 1u);
    while (bar_ld(ctr) < target) __builtin_amdgcn_s_sleep(1);
    __builtin_amdgcn_fence(__ATOMIC_ACQUIRE, "agent");
    asm volatile("s_waitcnt vmcnt(0)" ::: "memory");
  }
  __syncthreads();
}

DI void xcd_barrier(unsigned* bar, unsigned xcc, unsigned nloc, unsigned nx, unsigned k) {
  asm volatile("s_waitcnt vmcnt(0)" ::: "memory");
  __syncthreads();
  if (threadIdx.x == 0) {
    const unsigned old = bar_add(&bar[1024 + 64 * xcc], 1u);
    if (old + 1u == k * nloc) {
      __builtin_amdgcn_fence(__ATOMIC_RELEASE, "agent");
      asm volatile("s_waitcnt vmcnt(0)" ::: "memory");
      const unsigned og = bar_add(&bar[3072], 1u);
      if (og + 1u == k * nx) bar_add(&bar[3136], 1u);
      else while (bar_ld(&bar[3136]) < k) __builtin_amdgcn_s_sleep(1);
      __builtin_amdgcn_fence(__ATOMIC_ACQUIRE, "agent");
      bar_add(&bar[2048 + 64 * xcc], 1u);
      asm volatile("s_waitcnt vmcnt(0)" ::: "memory");
    } else {
      while (bar_ld(&bar[2048 + 64 * xcc]) < k) __builtin_amdgcn_s_sleep(1);
      __builtin_amdgcn_fence(__ATOMIC_ACQUIRE, "agent");
      asm volatile("s_waitcnt vmcnt(0)" ::: "memory");
    }
  }
  __syncthreads();
}

__global__ void __launch_bounds__(512) mega(Params p) {
  extern __shared__ __attribute__((aligned(16))) char lds[];
  unsigned* bst = (unsigned*)(lds + LDS_BYTES);
  cg::grid_group grid = cg::this_grid();
  const int G = gridDim.x, bid = blockIdx.x;
  if (p.bar == nullptr) grid.sync();
  const unsigned xcc = xcc_id();
  if (threadIdx.x == 0) bar_add(&p.bar[64 * xcc], 1u);
  phase_prologue(p);
  grid_barrier(&p.bar[3200], (unsigned)G);
  if (threadIdx.x == 0) {
    unsigned mine = 0, cnt = 0;
    for (unsigned j = 0; j < 16; ++j) { const unsigned c = bar_ld(&p.bar[64 * j]); cnt += c > 0u ? 1u : 0u; mine = (j == xcc) ? c : mine; }
    bst[0] = mine; bst[1] = cnt;
  }
  __syncthreads();
  const unsigned nloc = bst[0], nx = bst[1];
  unsigned nbar = 0;
  const int GW = G; const int wb = bid;
#define GRID_BARRIER() { ++nbar; xcd_barrier(p.bar, xcc, nloc, nx, nbar); }
#pragma unroll 1
  for (int layer = 0; layer < 2; ++layer) {
    __syncthreads();
    {
      pg8::Gemm gg; gg.A = p.xb; gg.Bt = p.wint + (size_t)layer * kNW * 1024; gg.M = kT; gg.N = kNW; gg.K = 1024;
      pg8::StaticOrder so; so.init(kT, kNW, G, bid);
      EpiIn ei; ei.proj = p.proj; ei.kdt = p.kdt; ei.vrt = p.vrt; ei.vst = p.vst; ei.vwt = p.vwt; ei.rot = p.rot;
      pg8::gemm_phase<EpiIn, pg8::StaticOrder, false>((PG8_LAS unsigned char*)lds, gg, so, ei, nullptr);
    }
    GRID_BARRIER()
#pragma unroll 1
    for (int u = (G == 256 ? (bid + 128) & 255 : wb); u < 128; u += GW) nsa_cmp_unit(p, layer, u, lds);
#pragma unroll 1
    for (int u = wb; u < 256; u += GW) lru_local_unit(p, layer, u, lds);
#pragma unroll 1
    for (int u = wb; u < 256; u += GW) ret_kv_unit(p, u);
    GRID_BARRIER()
#pragma unroll 1
    for (int u = wb; u < 512; u += GW) nsa_unit(p, u, lds);
#pragma unroll 1
    for (int u = wb; u < 256; u += GW) ret_out_unit(p, u, lds);
#pragma unroll 1
    for (int u = wb; u < 256; u += GW) lru_out_unit(p, u);
    GRID_BARRIER()
    __syncthreads();
    {
      pg8::Gemm gg; gg.A = p.xb; gg.Bt = p.woutt + (size_t)layer * 1024 * 1024; gg.M = kT; gg.N = 1024; gg.K = 1024;
      pg8::StaticOrder so; so.init(kT, 1024, G, bid);
      EpiOut eo; eo.res = layer == 0 ? p.x : p.out; eo.out = p.out;
      pg8::gemm_phase<EpiOut, pg8::StaticOrder, false>((PG8_LAS unsigned char*)lds, gg, so, eo, nullptr);
    }
    GRID_BARRIER()
    ln_phase(p, layer);
    if (layer == 0) GRID_BARRIER()
  }
#undef GRID_BARRIER
}

extern "C" void kernel_launch(void* const* d_in, const int* in_sizes, int n_in, void* d_out, int out_size, void* d_ws,
                              size_t ws_size, hipStream_t stream) {
  static int grid_blocks = 0;
  if (!grid_blocks) {
    int dev = 0, cus = 0, per_cu = 0;
    (void)hipGetDevice(&dev);
    (void)hipDeviceGetAttribute(&cus, hipDeviceAttributeMultiprocessorCount, dev);
    (void)hipFuncSetAttribute((const void*)mega, hipFuncAttributeMaxDynamicSharedMemorySize, LDS_BYTES + 16);
    (void)hipOccupancyMaxActiveBlocksPerMultiprocessor(&per_cu, mega, 512, LDS_BYTES + 16);
    if (per_cu > 1) per_cu = 1;
    if (per_cu < 1) per_cu = 1;
    grid_blocks = cus * per_cu;
  }
  Params p{};
  p.x = (const float*)d_in[0]; p.w_in = (const float*)d_in[1]; p.w_out = (const float*)d_in[2];
  p.ln_g = (const float*)d_in[3]; p.ln_b = (const float*)d_in[4]; p.cmp_pos = (const float*)d_in[5];
  p.cmp_w = (const float*)d_in[6]; p.conv_w = (const float*)d_in[7]; p.conv_b = (const float*)d_in[8];
  p.w_a = (const float*)d_in[9]; p.b_a = (const float*)d_in[10]; p.w_x = (const float*)d_in[11];
  p.b_x = (const float*)d_in[12]; p.lam = (const float*)d_in[13];
  p.out = (float*)d_out;
  char* ws = (char*)d_ws;
  size_t off = 0;
  auto take = [&](size_t bytes) { char* r = ws + off; off += (bytes + 255) & ~(size_t)255; return r; };
  p.xb = (bf16*)take((size_t)kT * 1024 * 2);
  p.wint = (bf16*)take((size_t)2 * kNW * 1024 * 2);
  p.woutt = (bf16*)take((size_t)2 * 1024 * 1024 * 2);
  p.cmpwt = (bf16*)take((size_t)4 * 64 * 2048 * 2);
  p.proj = (bf16*)take((size_t)kT * kNP * 2);
  p.kdt = (bf16*)take((size_t)16 * 64 * 4096 * 2);
  p.vrt = (bf16*)take((size_t)16 * 64 * 4096 * 2);
  p.vst = (bf16*)take((size_t)8 * 64 * 4096 * 2);
  p.vwt = (bf16*)take((size_t)8 * 64 * 4096 * 2);
  p.kc = (bf16*)take((size_t)8 * 256 * 64 * 2);
  p.vct = (bf16*)take((size_t)8 * 64 * 256 * 2);
  p.wat = (bf16*)take((size_t)8 * 64 * 64 * 2);
  p.wxt = (bf16*)take((size_t)8 * 64 * 64 * 2);
  p.cmpbp = (float*)take((size_t)64 * 32 * 4);
  p.rot = (float*)take((size_t)4096 * 32 * 2 * 4);
  p.kvc = (float*)take((size_t)512 * 4096 * 4);
  p.cuma = (float*)take((size_t)kT * 256 * 4);
  p.hloc = (float*)take((size_t)kT * 256 * 4);
  p.suma = (float*)take((size_t)4 * 128 * 256 * 4);
  p.sumh = (float*)take((size_t)4 * 128 * 256 * 4);
  p.bar = (unsigned*)take(16384);
  if (off > ws_size) { fprintf(stderr, "workspace too small: need %zu have %zu\n", off, ws_size); return; }
  (void)hipMemsetAsync(p.bar, 0, 16384, stream);
  void* args[] = {&p};
  hipError_t e = hipLaunchCooperativeKernel((void*)mega, dim3(grid_blocks), dim3(512), args, LDS_BYTES + 16, stream);
  if (e != hipSuccess) fprintf(stderr, "cooperative launch failed: %s (grid %d)\n", hipGetErrorString(e), grid_blocks);
}
```

```cpp
#include <hip/hip_runtime.h>
#include <hip/hip_cooperative_groups.h>
#include <stdint.h>
#include <cstdio>
namespace cg = cooperative_groups;

typedef unsigned short bf16;
typedef __attribute__((ext_vector_type(8))) short bf16x8;
typedef __attribute__((ext_vector_type(4))) short s16x4;
typedef __attribute__((ext_vector_type(16))) float f32x16;
typedef __bf16 bf2_t __attribute__((ext_vector_type(2)));
typedef float fl2_t __attribute__((ext_vector_type(2)));
#define DI __device__ __forceinline__
#define MFMA32(a, b, c) __builtin_amdgcn_mfma_f32_32x32x16_bf16((a), (b), (c), 0, 0, 0)

#ifndef USE_CG
#define USE_CG 0
#endif
#ifndef COOP
#define COOP 1
#endif

constexpr int kT = 16384, kS = 4096, kDM = 1024, kNP = 3456, kDIN = 3352, kNW = 3584;
constexpr int LDK = 72;
constexpr int LDV = 136;
constexpr int LDS_BYTES = 131072;
constexpr int NPHASE = 11;

constexpr int C_RQ = 0, C_RK = 256, C_RV = 512, C_RG = 768, C_NQ = 1024, C_NKC = 1536, C_NVC = 1664, C_NKS = 1792,
              C_NVS = 1920, C_NKW = 2048, C_NVW = 2176, C_NG = 2304, C_NGL = 2816, C_LX = 2840, C_LG = 3096;

struct Params {
  const float *x, *w_in, *w_out, *ln_g, *ln_b, *cmp_pos, *cmp_w, *conv_w, *conv_b, *w_a, *b_a, *w_x, *b_x, *lam;
  float* out;
  bf16 *xb, *wint, *woutt, *cmpwt, *proj, *kdt, *vrt, *vst, *vwt, *kc, *vct, *wat, *wxt;
  float *cmpbp, *rot, *kvc, *cuma, *hloc, *suma, *sumh;
  unsigned* bar;
};

DI unsigned pack2(float a, float b) { fl2_t f = {a, b}; bf2_t r = __builtin_convertvector(f, bf2_t); return __builtin_bit_cast(unsigned, r); }
DI bf16 f2bf(float a) { return (bf16)(pack2(a, 0.f) & 0xffffu); }
DI float bf2f(bf16 b) { return __uint_as_float(((unsigned)b) << 16); }
DI int crow(int i, int hh) { return (i & 3) + 8 * (i >> 2) + 4 * hh; }
DI float sigmoidf_(float x) { return 1.f / (1.f + __expf(-x)); }
DI float siluf_(float x) { return x / (1.f + __expf(-x)); }
DI float xor32x(float v, int hh) {
  auto r = __builtin_amdgcn_permlane32_swap(__float_as_uint(v), __float_as_uint(v), false, false);
  return __uint_as_float(hh ? r[0] : r[1]);
}
DI float rmax32(float v) { auto r = __builtin_amdgcn_permlane32_swap(__float_as_uint(v), __float_as_uint(v), false, false); return fmaxf(__uint_as_float(r[0]), __uint_as_float(r[1])); }
DI float rsum32(float v) { auto r = __builtin_amdgcn_permlane32_swap(__float_as_uint(v), __float_as_uint(v), false, false); return __uint_as_float(r[0]) + __uint_as_float(r[1]); }
DI float xor32(float v) { return __shfl_xor(v, 32, 64); }
DI float max3f(float a, float b, float c) { float r; asm("v_max3_f32 %0, %1, %2, %3" : "=v"(r) : "v"(a), "v"(b), "v"(c)); return r; }
DI f32x16 zero16() { f32x16 z = {0.f, 0.f, 0.f, 0.f, 0.f, 0.f, 0.f, 0.f, 0.f, 0.f, 0.f, 0.f, 0.f, 0.f, 0.f, 0.f}; return z; }

DI bf16x8 pack_half(const f32x16& x, int s) {
  uint4 u;
  if (s == 0) { u.x = pack2(x[0], x[1]); u.y = pack2(x[2], x[3]); u.z = pack2(x[4], x[5]); u.w = pack2(x[6], x[7]); }
  else        { u.x = pack2(x[8], x[9]); u.y = pack2(x[10], x[11]); u.z = pack2(x[12], x[13]); u.w = pack2(x[14], x[15]); }
  return __builtin_bit_cast(bf16x8, u);
}

struct QF { bf16x8 q0, q1, q2, q3; };
DI f32x16 qk_tile(const bf16* sK, int kstride, const QF& qf, int l31, int hh) {
  f32x16 s = zero16();
  const bf16* r = sK + l31 * kstride + hh * 8;
  s = MFMA32(*(const bf16x8*)(r), qf.q0, s);
  s = MFMA32(*(const bf16x8*)(r + 16), qf.q1, s);
  s = MFMA32(*(const bf16x8*)(r + 32), qf.q2, s);
  s = MFMA32(*(const bf16x8*)(r + 48), qf.q3, s);
  return s;
}
DI void pv_tile(f32x16* o, const bf16* sVt, int vstride, bf16x8 p0, bf16x8 p1, int l31, int hh) {
#pragma unroll
  for (int et = 0; et < 2; ++et) {
#pragma unroll
    for (int s = 0; s < 2; ++s) {
      const bf16* row = sVt + (et * 32 + l31) * vstride + 16 * s + 4 * hh;
      s16x4 lo = *(const s16x4*)(row);
      s16x4 hi = *(const s16x4*)(row + 8);
      bf16x8 a = __builtin_shufflevector(lo, hi, 0, 1, 2, 3, 4, 5, 6, 7);
      o[et] = MFMA32(a, s == 0 ? p0 : p1, o[et]);
    }
  }
}

template <int PART>
DI void phase_prologue(const Params& p, int vbid, int nvb) {
  int tid_ = threadIdx.x; asm volatile("" : "+v"(tid_));
  const int gtid = vbid * 512 + tid_, gsz = nvb * 512;
  if (PART == 1)
  for (int i0 = gtid; i0 < kT * kDM / 8; i0 += 4 * gsz) {
    float4 a[4], b[4];
#pragma unroll
    for (int j = 0; j < 4; ++j) {
      int ii = i0 + j * gsz; if (ii >= kT * kDM / 8) ii = i0;
      const float4* src = (const float4*)(p.x + (size_t)ii * 8);
      a[j] = src[0]; b[j] = src[1];
    }
#pragma unroll
    for (int j = 0; j < 4; ++j) {
      uint4 u; u.x = pack2(a[j].x, a[j].y); u.y = pack2(a[j].z, a[j].w); u.z = pack2(b[j].x, b[j].y); u.w = pack2(b[j].z, b[j].w);
      int ii = i0 + j * gsz; if (ii >= kT * kDM / 8) ii = i0;
      *(uint4*)(p.xb + (size_t)ii * 8) = u;
    }
  }
  for (int i = gtid; i < 128 * kNW; i += gsz) {
    int kcl = i & 7; int r0 = i >> 3; int np = r0 % kNW; int r = r0 / kNW; int kc = (r & 15) * 8 + kcl; const int l = PART - 1;
    const int pp = np & 63;
    const int n = (np & ~63) + 16 * ((pp >> 5) & 1) + (pp & 15) + 32 * ((pp >> 4) & 1);
    float v[8];
#pragma unroll
    for (int j = 0; j < 8; ++j) v[j] = (n < kDIN) ? p.w_in[((size_t)l * 1024 + kc * 8 + j) * kDIN + n] : 0.f;
    uint4 u; u.x = pack2(v[0], v[1]); u.y = pack2(v[2], v[3]); u.z = pack2(v[4], v[5]); u.w = pack2(v[6], v[7]);
    *(uint4*)(p.wint + ((size_t)l * kNW + np) * 1024 + kc * 8) = u;
  }
  if (PART == 2)
  for (int i = gtid; i < 2 * 128 * 1024; i += gsz) {
    int kcl = i & 7; int r0 = i >> 3; int n = r0 & 1023; int r = r0 >> 10; int kc = (r & 15) * 8 + kcl; int l = r >> 4;
    float v[8];
#pragma unroll
    for (int j = 0; j < 8; ++j) v[j] = p.w_out[((size_t)l * 1024 + kc * 8 + j) * 1024 + n];
    uint4 u; u.x = pack2(v[0], v[1]); u.y = pack2(v[2], v[3]); u.z = pack2(v[4], v[5]); u.w = pack2(v[6], v[7]);
    *(uint4*)(p.woutt + ((size_t)l * 1024 + n) * 1024 + kc * 8) = u;
  }
  if (PART == 2)
  for (int i = gtid; i < 4 * 256 * 64; i += gsz) {
    int kcl = i & 7; int r0 = i >> 3; int e = r0 & 63; int r = r0 >> 6; int kc = (r & 31) * 8 + kcl; int lk = r >> 5;
    float v[8];
#pragma unroll
    for (int j = 0; j < 8; ++j) v[j] = p.cmp_w[((size_t)lk * 2048 + kc * 8 + j) * 64 + e];
    uint4 u; u.x = pack2(v[0], v[1]); u.y = pack2(v[2], v[3]); u.z = pack2(v[4], v[5]); u.w = pack2(v[6], v[7]);
    *(uint4*)(p.cmpwt + ((size_t)lk * 64 + e) * 2048 + kc * 8) = u;
  }
  if (PART == 2)
  for (int i = gtid; i < 8 * 64 * 8; i += gsz) {
    int dc = i & 7; int e = (i >> 3) & 63; int ln = i >> 9;
    float va[8], vx[8];
#pragma unroll
    for (int j = 0; j < 8; ++j) { va[j] = p.w_a[(ln * 64 + dc * 8 + j) * 64 + e]; vx[j] = p.w_x[(ln * 64 + dc * 8 + j) * 64 + e]; }
    uint4 u; u.x = pack2(va[0], va[1]); u.y = pack2(va[2], va[3]); u.z = pack2(va[4], va[5]); u.w = pack2(va[6], va[7]);
    *(uint4*)(p.wat + (ln * 64 + e) * 64 + dc * 8) = u;
    u.x = pack2(vx[0], vx[1]); u.y = pack2(vx[2], vx[3]); u.z = pack2(vx[4], vx[5]); u.w = pack2(vx[6], vx[7]);
    *(uint4*)(p.wxt + (ln * 64 + e) * 64 + dc * 8) = u;
  }
  {
    const int lane = tid_ & 63, gw = vbid * 8 + (tid_ >> 6);
    if (PART == 2 && gw < 64) {
      const int lk = gw >> 4, e0 = (gw & 15) * 4;
      float4 acc = make_float4(0.f, 0.f, 0.f, 0.f);
#pragma unroll 8
      for (int i = 0; i < 32; ++i) {
        int k = lane + 64 * i;
        float pz = p.cmp_pos[lk * 2048 + k];
        float4 wv = *(const float4*)(p.cmp_w + ((size_t)lk * 2048 + k) * 64 + e0);
        acc.x += pz * wv.x; acc.y += pz * wv.y; acc.z += pz * wv.z; acc.w += pz * wv.w;
      }
#pragma unroll
      for (int off = 32; off >= 1; off >>= 1) {
        acc.x += __shfl_xor(acc.x, off, 64); acc.y += __shfl_xor(acc.y, off, 64);
        acc.z += __shfl_xor(acc.z, off, 64); acc.w += __shfl_xor(acc.w, off, 64);
      }
      if (lane == 0) *(float4*)(p.cmpbp + gw * 32) = acc;
    }
  }
  if (PART == 1)
  for (int i = gtid; i < 4096 * 32; i += gsz) {
    int fi = i & 31, pos = i >> 5;
    float inv = (float)exp(-(double)fi * (9.210340371976184 / 32.0));
    float ang = (float)pos * inv;
    double rev = (double)ang * 0.15915494309189535;
    float fr = (float)(rev - rint(rev));
    float2 cs; cs.x = __builtin_amdgcn_cosf(fr); cs.y = __builtin_amdgcn_sinf(fr);
    ((float2*)p.rot)[i] = cs;
  }
}

template <int MODE>
DI void gemm_tile(const Params& p, int layer, int tm, int tn, char* lds) {
  int tid_ = threadIdx.x; asm volatile("" : "+v"(tid_));
  const int tid = tid_ & 255, lane = tid & 63, w = tid >> 6, l31 = lane & 31, hh = lane >> 5;
  bf16* sA = (bf16*)lds;
  if (tid_ >= 256) {
    const bf16* Ab = p.xb + (size_t)tm * 256 * 1024;
    const bf16* Bb = (MODE == 0 ? p.wint + (size_t)layer * kNP * 1024 : p.woutt + (size_t)layer * 1024 * 1024) + (size_t)tn * 128 * 1024;
    const int lrow = tid >> 3, lcc = tid & 7;
    const bf16* Ap = Ab + lrow * 1024 + lcc * 8;
    const bf16* Bp = Bb + lrow * 1024 + lcc * 8;
    uint4 Pa0, Pa1, Pa2, Pa3, Pa4, Pa5, Pa6, Pa7, Pb0, Pb1, Pb2, Pb3, Qa0, Qa1, Qa2, Qa3, Qa4, Qa5, Qa6, Qa7, Qb0, Qb1, Qb2, Qb3;
#define G_LOAD(R, kt_) { const bf16* Aq = Ap + (kt_) * 64; const bf16* Bq = Bp + (kt_) * 64; \
    R##a0 = *(const uint4*)(Aq); R##a1 = *(const uint4*)(Aq + 32 * 1024); R##a2 = *(const uint4*)(Aq + 64 * 1024); R##a3 = *(const uint4*)(Aq + 96 * 1024); \
    R##a4 = *(const uint4*)(Aq + 128 * 1024); R##a5 = *(const uint4*)(Aq + 160 * 1024); R##a6 = *(const uint4*)(Aq + 192 * 1024); R##a7 = *(const uint4*)(Aq + 224 * 1024); \
    R##b0 = *(const uint4*)(Bq); R##b1 = *(const uint4*)(Bq + 32 * 1024); R##b2 = *(const uint4*)(Bq + 64 * 1024); R##b3 = *(const uint4*)(Bq + 96 * 1024); }
#define G_STORE(R, buf_) { bf16* sAw = sA + (buf_) * (384 * LDK) + lrow * LDK + lcc * 8; bf16* sBw = sAw + 256 * LDK; \
    *(uint4*)(sAw) = R##a0; *(uint4*)(sAw + 32 * LDK) = R##a1; *(uint4*)(sAw + 64 * LDK) = R##a2; *(uint4*)(sAw + 96 * LDK) = R##a3; \
    *(uint4*)(sAw + 128 * LDK) = R##a4; *(uint4*)(sAw + 160 * LDK) = R##a5; *(uint4*)(sAw + 192 * LDK) = R##a6; *(uint4*)(sAw + 224 * LDK) = R##a7; \
    *(uint4*)(sBw) = R##b0; *(uint4*)(sBw + 32 * LDK) = R##b1; *(uint4*)(sBw + 64 * LDK) = R##b2; *(uint4*)(sBw + 96 * LDK) = R##b3; }
    G_LOAD(P, 0)
    __builtin_amdgcn_sched_barrier(0);
    G_LOAD(Q, 1)
    __builtin_amdgcn_sched_barrier(0);
    G_STORE(P, 0)
    G_LOAD(P, 2)
    __syncthreads();
#pragma unroll 1
    for (int kt = 0; kt < 16; kt += 2) {
      G_STORE(Q, 1)
      G_LOAD(Q, (kt + 3 < 16 ? kt + 3 : 15))
      __syncthreads();
      if (kt + 2 < 16) G_STORE(P, 0)
      G_LOAD(P, (kt + 4 < 16 ? kt + 4 : 15))
      __syncthreads();
    }
#undef G_LOAD
#undef G_STORE
    return;
  }
#define FR_LOAD(F, ks_) { F##b0 = *(const bf16x8*)(cB + (ks_) * 16); F##b1 = *(const bf16x8*)(cB + 32 * LDK + (ks_) * 16); \
      F##a0 = *(const bf16x8*)(cA + (ks_) * 16); F##a1 = *(const bf16x8*)(cA + 32 * LDK + (ks_) * 16); \
      F##a2 = *(const bf16x8*)(cA + 64 * LDK + (ks_) * 16); F##a3 = *(const bf16x8*)(cA + 96 * LDK + (ks_) * 16); }
#define FR_MMA(F) { if (MODE == 1) { \
      acc[0][0] = MFMA32(F##a0, F##b0, acc[0][0]); acc[0][1] = MFMA32(F##a0, F##b1, acc[0][1]); \
      acc[1][0] = MFMA32(F##a1, F##b0, acc[1][0]); acc[1][1] = MFMA32(F##a1, F##b1, acc[1][1]); \
      acc[2][0] = MFMA32(F##a2, F##b0, acc[2][0]); acc[2][1] = MFMA32(F##a2, F##b1, acc[2][1]); \
      acc[3][0] = MFMA32(F##a3, F##b0, acc[3][0]); acc[3][1] = MFMA32(F##a3, F##b1, acc[3][1]); \
    } else {     \
      acc[0][0] = MFMA32(F##b0, F##a0, acc[0][0]); acc[0][1] = MFMA32(F##b1, F##a0, acc[0][1]); \
      acc[1][0] = MFMA32(F##b0, F##a1, acc[1][0]); acc[1][1] = MFMA32(F##b1, F##a1, acc[1][1]); \
      acc[2][0] = MFMA32(F##b0, F##a2, acc[2][0]); acc[2][1] = MFMA32(F##b1, F##a2, acc[2][1]); \
      acc[3][0] = MFMA32(F##b0, F##a3, acc[3][0]); acc[3][1] = MFMA32(F##b1, F##a3, acc[3][1]); } }
  f32x16 acc[4][2];
#pragma unroll
  for (int mi = 0; mi < 4; ++mi) { acc[mi][0] = zero16(); acc[mi][1] = zero16(); }
  const int wm = w >> 1, wn = w & 1;
  __syncthreads();
#pragma unroll 1
  for (int kt = 0; kt < 16; ++kt) {
    const bf16* cA = sA + (kt & 1) * (384 * LDK) + (wm * 128 + l31) * LDK + hh * 8;
    const bf16* cB = sA + (kt & 1) * (384 * LDK) + (256 + wn * 64 + l31) * LDK + hh * 8;
    bf16x8 Xa0, Xa1, Xa2, Xa3, Xb0, Xb1, Ya0, Ya1, Ya2, Ya3, Yb0, Yb1;
    FR_LOAD(X, 0)
    FR_LOAD(Y, 1) __builtin_amdgcn_sched_barrier(0); FR_MMA(X) __builtin_amdgcn_sched_barrier(0);
    FR_LOAD(X, 2) __builtin_amdgcn_sched_barrier(0); FR_MMA(Y) __builtin_amdgcn_sched_barrier(0);
    FR_LOAD(Y, 3) __builtin_amdgcn_sched_barrier(0); FR_MMA(X) __builtin_amdgcn_sched_barrier(0);
    FR_MMA(Y)
    __syncthreads();
  }
#undef FR_LOAD
#undef FR_MMA
  const int m0 = tm * 256 + wm * 128, n0 = tn * 128 + wn * 64;
  if (MODE == 1) {
    const float* res = layer == 0 ? p.x : p.out;
    const float alpha = 1.41421356237f;
#pragma unroll
    for (int mi = 0; mi < 4; ++mi)
#pragma unroll
      for (int ni = 0; ni < 2; ++ni) {
        float rv[16];
#pragma unroll
        for (int i = 0; i < 16; ++i)
          rv[i] = res[(size_t)(m0 + mi * 32 + crow(i, hh)) * 1024 + n0 + ni * 32 + l31];
#pragma unroll
        for (int i = 0; i < 16; ++i)
          p.out[(size_t)(m0 + mi * 32 + crow(i, hh)) * 1024 + n0 + ni * 32 + l31] = alpha * rv[i] + acc[mi][ni][i];
      }
    return;
  }
  const int seg = n0 >> 6;
  const bool is_rot = seg < 8;
  const float scale = (seg >= 4 && seg < 8) ? 0.125f : ((seg >= 16 && seg < 24) ? 0.125f * 1.4426950408889634f : 1.f);
  bf16* tdst = nullptr; int hd = 0, nh = 1; float lg2g = 0.f;
  if (seg >= 4 && seg < 8) { tdst = p.kdt; hd = seg - 4; nh = 4; lg2g = log2f(1.f - exp2f(-5.f - (float)hd)); }
  else if (seg >= 8 && seg < 12) { tdst = p.vrt; hd = seg - 8; nh = 4; }
  else if (seg == 30 || seg == 31) { tdst = p.vst; hd = seg - 30; nh = 2; }
  else if (seg == 34 || seg == 35) { tdst = p.vwt; hd = seg - 34; nh = 2; }
  const bool natural = !((seg >= 8 && seg < 12) || seg == 30 || seg == 31 || seg == 34 || seg == 35);
#pragma unroll
  for (int mi = 0; mi < 4; ++mi) {
    const int row = m0 + mi * 32 + l31;
    const int bb = row >> 12, sq = row & 4095;
    if (is_rot) {
#pragma unroll
      for (int g4 = 0; g4 < 4; ++g4) {
        const float4* rp = (const float4*)(p.rot + ((size_t)sq * 32 + 8 * g4 + 4 * hh) * 2);
        float4 c01 = rp[0], c23 = rp[1];
        float cs[4] = {c01.x, c01.z, c23.x, c23.z}, sn[4] = {c01.y, c01.w, c23.y, c23.w};
#pragma unroll
        for (int j = 0; j < 4; ++j) {
          float v0 = acc[mi][0][g4 * 4 + j], v1 = acc[mi][1][g4 * 4 + j];
          acc[mi][0][g4 * 4 + j] = v0 * cs[j] - v1 * sn[j];
          acc[mi][1][g4 * 4 + j] = v0 * sn[j] + v1 * cs[j];
        }
      }
    }
    if (scale != 1.f) {
#pragma unroll
      for (int i = 0; i < 16; ++i) { acc[mi][0][i] *= scale; acc[mi][1][i] *= scale; }
    }
    if (natural) {
#pragma unroll
      for (int ni = 0; ni < 2; ++ni)
#pragma unroll
        for (int g4 = 0; g4 < 4; ++g4) {
          uint2 u; u.x = pack2(acc[mi][ni][g4 * 4 + 0], acc[mi][ni][g4 * 4 + 1]); u.y = pack2(acc[mi][ni][g4 * 4 + 2], acc[mi][ni][g4 * 4 + 3]);
          *(uint2*)(p.proj + (size_t)row * kNP + n0 + ni * 32 + 8 * g4 + 4 * hh) = u;
        }
    }
    if (tdst) {
      const float kd = (lg2g != 0.f) ? exp2f((float)(127 - (sq & 127)) * lg2g) : 1.f;
      bf16* tb = tdst + ((size_t)(bb * nh + hd) * 64) * 4096 + sq;
#pragma unroll
      for (int ni = 0; ni < 2; ++ni)
#pragma unroll
        for (int i = 0; i < 16; ++i)
          tb[(size_t)(ni * 32 + crow(i, hh)) * 4096] = f2bf(acc[mi][ni][i] * kd);
    }
  }
}

DI void ret_kv_unit(const Params& p, int u0) {
  int tid_ = threadIdx.x; asm volatile("" : "+v"(tid_));
  const int u = u0 + 256 * (tid_ >> 8);
  const int tid = tid_ & 255, lane = tid & 63, w = tid >> 6, l31 = lane & 31, hh = lane >> 5;
  const int bh = u >> 5, n = u & 31;
  const int mi = w >> 1, ni = w & 1;
  const bf16* ka = p.kdt + ((size_t)bh * 64 + mi * 32 + l31) * 4096 + n * 128 + hh * 8;
  const bf16* vb = p.vrt + ((size_t)bh * 64 + ni * 32 + l31) * 4096 + n * 128 + hh * 8;
  f32x16 acc = zero16();
#pragma unroll
  for (int ks = 0; ks < 8; ++ks) {
    bf16x8 a = *(const bf16x8*)(ka + ks * 16);
    bf16x8 b = *(const bf16x8*)(vb + ks * 16);
    acc = MFMA32(a, b, acc);
  }
#pragma unroll
  for (int i = 0; i < 16; ++i)
    p.kvc[(size_t)u * 4096 + (mi * 32 + crow(i, hh)) * 64 + ni * 32 + l31] = acc[i];
}

DI void nsa_cmp_unit(const Params& p, int layer, int u, char* lds) {
  if (threadIdx.x >= 256) {
    for (int i_ = 0; i_ < 2; ++i_) __syncthreads();
    return;
  }
  int tid_ = threadIdx.x; asm volatile("" : "+v"(tid_));
  const int tid = tid_, lane = tid & 63, w = tid >> 6, l31 = lane & 31, hh = lane >> 5;
  const int mb2 = u & 7, kv = (u >> 3) & 1, g = (u >> 4) & 1, b = u >> 5;
  const int mb = mb2 >> 1, mt0 = mb2 & 1;
  float* red = (float*)lds;
  const bf16* brow = p.cmpwt + ((size_t)(layer * 2 + kv) * 64 + l31) * 2048 + hh * 8;
  const float* bp = p.cmpbp + (layer * 2 + kv) * 16 * 32;
#pragma unroll 1
  for (int mt = mt0; mt <= mt0; ++mt) {
    int n = mb * 64 + mt * 32 + l31; int nc = n > 254 ? 254 : n;
    const bf16* arow = p.proj + ((size_t)(b * 4096 + 16 * nc)) * kNP + (kv ? C_NVC : C_NKC) + g * 64 + hh * 8;
    f32x16 acc0 = zero16(), acc1 = zero16();
#pragma unroll 4
    for (int lt = w * 8; lt < w * 8 + 8; ++lt) {
#pragma unroll
      for (int ks = 0; ks < 4; ++ks) {
        bf16x8 a = *(const bf16x8*)(arow + (size_t)lt * kNP + ks * 16);
        bf16x8 b0 = *(const bf16x8*)(brow + lt * 64 + ks * 16);
        bf16x8 b1 = *(const bf16x8*)(brow + 32 * 2048 + lt * 64 + ks * 16);
        acc0 = MFMA32(a, b0, acc0);
        acc1 = MFMA32(a, b1, acc1);
      }
    }
    __syncthreads();
#pragma unroll
    for (int i = 0; i < 16; ++i) {
      red[(w * 32 + crow(i, hh)) * 64 + l31] = acc0[i];
      red[(w * 32 + crow(i, hh)) * 64 + 32 + l31] = acc1[i];
    }
    __syncthreads();
    if (kv == 0) {
      for (int idx = tid; idx < 2048; idx += 256) {
        int e = idx & 63, r = idx >> 6;
        float sv = red[idx] + red[2048 + idx] + red[4096 + idx] + red[6144 + idx] + bp[(e >> 2) * 32 + (e & 3)];
        int nn = mb * 64 + mt * 32 + r;
        if (nn > 254) sv = 0.f;
        p.kc[((size_t)(b * 2 + g) * 256 + nn) * 64 + e] = f2bf(sv);
      }
    } else {
      for (int idx = tid; idx < 2048; idx += 256) {
        int r = idx & 31, e = idx >> 5;
        int ridx = r * 64 + e;
        float sv = red[ridx] + red[2048 + ridx] + red[4096 + ridx] + red[6144 + ridx] + bp[(e >> 2) * 32 + (e & 3)];
        int nn = mb * 64 + mt * 32 + r;
        if (nn > 254) sv = 0.f;
        p.vct[((size_t)(b * 2 + g) * 64 + e) * 256 + nn] = f2bf(sv);
      }
    }
  }
}

DI void lru_local_unit(const Params& p, int layer, int u, char* lds) {
  if (threadIdx.x >= 256) {
    for (int i_ = 0; i_ < 12; ++i_) __syncthreads();
    return;
  }
  int tid_ = threadIdx.x; asm volatile("" : "+v"(tid_));
  const int tid = tid_, lane = tid & 63, w = tid >> 6, l31 = lane & 31, hh = lane >> 5;
  const int half = u & 1, chunk = (u >> 1) & 31, b = u >> 6;
  bf16* xcb = (bf16*)lds;
  float* bufA = (float*)(lds + 32 * LDV * 2);
  float* bufU = bufA + 32 * 128;
  const int cl = tid & 127, tg = tid >> 7, chc = half * 128 + cl;
  const float cw0 = p.conv_w[(layer * 4 + 0) * 256 + chc], cw1 = p.conv_w[(layer * 4 + 1) * 256 + chc];
  const float cw2 = p.conv_w[(layer * 4 + 2) * 256 + chc], cw3 = p.conv_w[(layer * 4 + 3) * 256 + chc];
  const float cb = p.conv_b[layer * 256 + chc];
  const bf16* lx = p.proj + (size_t)(b * 4096) * kNP + C_LX + chc;
  const int nbl = w >> 1, ni = w & 1;
  const int nb = half * 2 + nbl;
  const bf16* wa = p.wat + ((size_t)(layer * 4 + nb) * 64 + ni * 32 + l31) * 64 + hh * 8;
  const bf16* wx = p.wxt + ((size_t)(layer * 4 + nb) * 64 + ni * 32 + l31) * 64 + hh * 8;
  const int chl = nbl * 64 + ni * 32 + l31, ch = half * 128 + chl;
  const float ba = p.b_a[layer * 256 + ch], bx = p.b_x[layer * 256 + ch];
  const float sp = log1pf(expf(-p.lam[layer * 256 + ch]));
  float hs = 0.f, As = 1.f;
  float xv[19];
  {
    const int s0 = chunk * 128 + tg * 16;
#pragma unroll
    for (int t = 0; t < 19; ++t) { int sidx = s0 - 3 + t; xv[t] = sidx >= 0 ? bf2f(lx[(size_t)sidx * kNP]) : 0.f; }
  }
#pragma unroll 1
  for (int sc = 0; sc < 4; ++sc) {
    __syncthreads();
    {
#pragma unroll
      for (int t = 0; t < 16; ++t) {
        float xc = xv[t] * cw0 + xv[t + 1] * cw1 + xv[t + 2] * cw2 + xv[t + 3] * cw3 + cb;
        xcb[(tg * 16 + t) * LDV + cl] = f2bf(xc);
        bufU[(tg * 16 + t) * 128 + cl] = xc;
      }
    }
    __syncthreads();
    if (sc < 3) {
      const int s1 = chunk * 128 + (sc + 1) * 32 + tg * 16;
#pragma unroll
      for (int t = 0; t < 19; ++t) xv[t] = bf2f(lx[(size_t)(s1 - 3 + t) * kNP]);
    }
    {
      f32x16 ra = zero16(), rx = zero16();
#pragma unroll
      for (int ks = 0; ks < 4; ++ks) {
        bf16x8 a = *(const bf16x8*)(xcb + l31 * LDV + nbl * 64 + ks * 16 + hh * 8);
        bf16x8 b0 = *(const bf16x8*)(wa + ks * 16);
        bf16x8 b1 = *(const bf16x8*)(wx + ks * 16);
        ra = MFMA32(a, b0, ra);
        rx = MFMA32(a, b1, rx);
      }
#pragma unroll
      for (int i = 0; i < 16; ++i) {
        int t = crow(i, hh);
        float r = sigmoidf_(ra[i] + ba);
        float ig = sigmoidf_(rx[i] + bx);
        float log_a = -8.f * r * sp;
        float a = __expf(log_a);
        float xc = bufU[t * 128 + chl];
        float uu = __builtin_amdgcn_sqrtf(-expm1f(2.f * log_a)) * (ig * xc);
        bufA[t * 128 + chl] = a;
        bufU[t * 128 + chl] = uu;
      }
    }
    __syncthreads();
    if (tid < 128) {
      const size_t tokb = (size_t)b * 4096 + chunk * 128 + sc * 32;
#pragma unroll 8
      for (int t = 0; t < 32; ++t) {
        float a = bufA[t * 128 + tid], uu = bufU[t * 128 + tid];
        hs = a * hs + uu; As *= a;
        p.cuma[(tokb + t) * 256 + chc] = As;
        p.hloc[(tokb + t) * 256 + chc] = hs;
      }
    }
  }
  if (tid < 128) {
    p.suma[(b * 32 + chunk) * 256 + chc] = As;
    p.sumh[(b * 32 + chunk) * 256 + chc] = hs;
  }
}

DI void lru_out_unit(const Params& p, int u) {
  int tid_ = threadIdx.x; asm volatile("" : "+v"(tid_));
  const int tid = tid_;
  const int half = u & 1, chunk = (u >> 1) & 31, b = u >> 6;
  const int cl = tid & 127, tg = tid >> 7, ch = half * 128 + cl;
  float H = 0.f;
  {
    const float* sa = p.suma + (size_t)(b * 32) * 256 + ch;
    const float* sh = p.sumh + (size_t)(b * 32) * 256 + ch;
    int m = 0;
    for (; m + 8 <= chunk; m += 8) {
      float av[8], hv[8];
#pragma unroll
      for (int j = 0; j < 8; ++j) { av[j] = sa[(m + j) * 256]; hv[j] = sh[(m + j) * 256]; }
#pragma unroll
      for (int j = 0; j < 8; ++j) H = av[j] * H + hv[j];
    }
    for (; m < chunk; ++m) H = sa[m * 256] * H + sh[m * 256];
  }
  const size_t tok0 = (size_t)b * 4096 + chunk * 128 + tg * 32;
#pragma unroll 1
  for (int t8 = 0; t8 < 32; t8 += 8) {
    float hv[8], cv[8], gv[8];
#pragma unroll
    for (int j = 0; j < 8; ++j) {
      size_t tok = tok0 + t8 + j;
      hv[j] = p.hloc[tok * 256 + ch]; cv[j] = p.cuma[tok * 256 + ch]; gv[j] = bf2f(p.proj[tok * kNP + C_LG + ch]);
    }
#pragma unroll
    for (int j = 0; j < 8; ++j) {
      size_t tok = tok0 + t8 + j;
      p.xb[tok * 1024 + 768 + ch] = f2bf((hv[j] + cv[j] * H) * siluf_(gv[j]));
    }
  }
}

DI void ret_out_unit(const Params& p, int u0, char* lds0) {
  int tid_ = threadIdx.x; asm volatile("" : "+v"(tid_));
  const int vb = tid_ >> 8;
  const int u = u0 + 256 * vb;
  char* lds = lds0 + vb * 45056;
  const int tid = tid_ & 255, lane = tid & 63, w = tid >> 6, l31 = lane & 31, hh = lane >> 5;
  const int bh = u >> 5, n = u & 31, b = bh >> 2, h = bh & 3;
  bf16* sK = (bf16*)lds;
  bf16* sVt = sK + 128 * LDK;
  bf16* sSt = sVt + 64 * LDV;
  const int tok0 = b * 4096 + n * 128;
  const float lg2g = log2f(1.f - exp2f(-5.f - (float)h));
  __syncthreads();
#pragma unroll
  for (int i = 0; i < 4; ++i) {
    int c = tid + 256 * i;
    { int row = c >> 3, cc = c & 7;
      *(uint4*)(sK + row * LDK + cc * 8) = *(const uint4*)(p.proj + (size_t)(tok0 + row) * kNP + C_RK + h * 64 + cc * 8); }
    { int row = c >> 4, cc = c & 15;
      *(uint4*)(sVt + row * LDV + cc * 8) = *(const uint4*)(p.vrt + ((size_t)bh * 64 + row) * 4096 + n * 128 + cc * 8); }
  }
  {
    const float cd = exp2f(128.f * lg2g);
    float st[16];
#pragma unroll
    for (int j = 0; j < 16; ++j) st[j] = 0.f;
    const float* kvb = p.kvc + (size_t)(bh * 32) * 4096 + tid * 16;
    int m = 0;
    for (; m + 2 <= n; m += 2) {
      const float4* s0 = (const float4*)(kvb + (size_t)m * 4096);
      const float4* s1 = (const float4*)(kvb + (size_t)(m + 1) * 4096);
      float4 a0 = s0[0], a1 = s0[1], a2 = s0[2], a3 = s0[3];
      float4 c0 = s1[0], c1 = s1[1], c2 = s1[2], c3 = s1[3];
      st[0] = (st[0] * cd + a0.x) * cd + c0.x; st[1] = (st[1] * cd + a0.y) * cd + c0.y; st[2] = (st[2] * cd + a0.z) * cd + c0.z; st[3] = (st[3] * cd + a0.w) * cd + c0.w;
      st[4] = (st[4] * cd + a1.x) * cd + c1.x; st[5] = (st[5] * cd + a1.y) * cd + c1.y; st[6] = (st[6] * cd + a1.z) * cd + c1.z; st[7] = (st[7] * cd + a1.w) * cd + c1.w;
      st[8] = (st[8] * cd + a2.x) * cd + c2.x; st[9] = (st[9] * cd + a2.y) * cd + c2.y; st[10] = (st[10] * cd + a2.z) * cd + c2.z; st[11] = (st[11] * cd + a2.w) * cd + c2.w;
      st[12] = (st[12] * cd + a3.x) * cd + c3.x; st[13] = (st[13] * cd + a3.y) * cd + c3.y; st[14] = (st[14] * cd + a3.z) * cd + c3.z; st[15] = (st[15] * cd + a3.w) * cd + c3.w;
    }
    if (m < n) {
      const float4* src = (const float4*)(kvb + (size_t)m * 4096);
      float4 a0 = src[0], a1 = src[1], a2 = src[2], a3 = src[3];
      st[0] = st[0] * cd + a0.x; st[1] = st[1] * cd + a0.y; st[2] = st[2] * cd + a0.z; st[3] = st[3] * cd + a0.w;
      st[4] = st[4] * cd + a1.x; st[5] = st[5] * cd + a1.y; st[6] = st[6] * cd + a1.z; st[7] = st[7] * cd + a1.w;
      st[8] = st[8] * cd + a2.x; st[9] = st[9] * cd + a2.y; st[10] = st[10] * cd + a2.z; st[11] = st[11] * cd + a2.w;
      st[12] = st[12] * cd + a3.x; st[13] = st[13] * cd + a3.y; st[14] = st[14] * cd + a3.z; st[15] = st[15] * cd + a3.w;
    }
    const int d = tid >> 2, e0 = (tid & 3) * 16;
#pragma unroll
    for (int j = 0; j < 16; ++j) sSt[(e0 + j) * LDK + d] = f2bf(st[j]);
  }
  __syncthreads();
  const int qi = w * 32 + l31;
  const size_t tokq = (size_t)tok0 + qi;
  QF qf;
  {
    const bf16* qp = p.proj + tokq * kNP + C_RQ + h * 64 + hh * 8;
    qf.q0 = *(const bf16x8*)(qp); qf.q1 = *(const bf16x8*)(qp + 16); qf.q2 = *(const bf16x8*)(qp + 32); qf.q3 = *(const bf16x8*)(qp + 48);
  }
  f32x16 o[2];
  o[0] = zero16(); o[1] = zero16();
#pragma unroll
  for (int et = 0; et < 2; ++et) {
    const bf16* r = sSt + (et * 32 + l31) * LDK + hh * 8;
    o[et] = MFMA32(*(const bf16x8*)(r), qf.q0, o[et]);
    o[et] = MFMA32(*(const bf16x8*)(r + 16), qf.q1, o[et]);
    o[et] = MFMA32(*(const bf16x8*)(r + 32), qf.q2, o[et]);
    o[et] = MFMA32(*(const bf16x8*)(r + 48), qf.q3, o[et]);
  }
  const float qd = exp2f((float)(qi + 1) * lg2g);
#pragma unroll
  for (int i = 0; i < 16; ++i) { o[0][i] *= qd; o[1][i] *= qd; }
  for (int kt = 0; kt <= w; ++kt) {
    f32x16 s = qk_tile(sK + kt * 32 * LDK, LDK, qf, l31, hh);
#pragma unroll
    for (int i = 0; i < 16; ++i) {
      int key = kt * 32 + crow(i, hh);
      int diff = qi - key;
      s[i] = diff >= 0 ? s[i] * __builtin_amdgcn_exp2f((float)diff * lg2g) : 0.f;
    }
    bf16x8 p0 = pack_half(s, 0), p1 = pack_half(s, 1);
    pv_tile(o, sVt + kt * 32, LDV, p0, p1, l31, hh);
  }
  float s1 = 0.f;
#pragma unroll
  for (int i = 0; i < 16; ++i) s1 += o[0][i] + o[1][i];
  s1 = rsum32(s1);
  const float mean = s1 * (1.f / 64.f);
  float s2 = 0.f;
#pragma unroll
  for (int i = 0; i < 16; ++i) { float a = o[0][i] - mean, c = o[1][i] - mean; s2 += a * a + c * c; }
  s2 = rsum32(s2);
  const float rstd = rsqrtf(s2 * (1.f / 64.f) + 1e-5f);
  uint2 grv[2][4];
#pragma unroll
  for (int et = 0; et < 2; ++et)
#pragma unroll
    for (int g4 = 0; g4 < 4; ++g4) grv[et][g4] = *(const uint2*)(p.proj + tokq * kNP + C_RG + h * 64 + et * 32 + 8 * g4 + 4 * hh);
#pragma unroll
  for (int et = 0; et < 2; ++et)
#pragma unroll
    for (int g4 = 0; g4 < 4; ++g4) {
      int e = et * 32 + 8 * g4 + 4 * hh;
      uint2 gr = grv[et][g4];
      float g0 = __uint_as_float(gr.x << 16), g1 = __uint_as_float(gr.x & 0xffff0000u);
      float g2 = __uint_as_float(gr.y << 16), g3 = __uint_as_float(gr.y & 0xffff0000u);
      float y0 = (o[et][g4 * 4 + 0] - mean) * rstd * siluf_(g0);
      float y1 = (o[et][g4 * 4 + 1] - mean) * rstd * siluf_(g1);
      float y2 = (o[et][g4 * 4 + 2] - mean) * rstd * siluf_(g2);
      float y3 = (o[et][g4 * 4 + 3] - mean) * rstd * siluf_(g3);
      uint2 uo; uo.x = pack2(y0, y1); uo.y = pack2(y2, y3);
      *(uint2*)(p.xb + tokq * 1024 + h * 64 + e) = uo;
    }
}

#define KV_LOAD(kptr_, vptr_) { const bf16* kp_ = (kptr_); const bf16* vp_ = (vptr_); \
    rk0 = *(const uint4*)(kp_ + (size_t)lrow * kstride + lcc * 8); rk1 = *(const uint4*)(kp_ + (size_t)(lrow + 32) * kstride + lcc * 8); \
    rv0 = *(const uint4*)(vp_ + (size_t)lrow * vstride + lcc * 8); rv1 = *(const uint4*)(vp_ + (size_t)(lrow + 32) * vstride + lcc * 8); }

template <int MODE>
DI void nsa_branch(const bf16* kbase, int kstride, const bf16* vbase, int vstride, int jb_lo, int jb_hi, int full_lo, int full_hi,
                   bf16* sK0, bf16* sVt_unused, const QF& qf, int t, int nmax, unsigned sel_lo, unsigned sel_hi,
                   float& m, float& l, f32x16* o, float* imp_row, int tid, int l31, int hh, bool pre, uint4 pk, uint4 pv) {
  const int lrow = tid >> 3, lcc = tid & 7;
  uint4 rk0, rv0;
#define KV_LOAD8(kptr_, vptr_) { rk0 = *(const uint4*)((kptr_) + (size_t)lrow * kstride + lcc * 8); rv0 = *(const uint4*)((vptr_) + (size_t)lrow * vstride + lcc * 8); }
  if (pre) { rk0 = pk; rv0 = pv; }
  else KV_LOAD8(kbase + (size_t)jb_lo * 64 * kstride, vbase + jb_lo * 64)
  float inv_l = 0.f, carry = 0.f;
  if (MODE == 1) inv_l = l > 0.f ? 1.f / l : 0.f;
  __syncthreads();
  *(uint4*)(sK0 + lrow * LDK + lcc * 8) = rk0;
  *(uint4*)(sK0 + 64 * LDK + lrow * LDK + lcc * 8) = rv0;
  if (jb_lo < jb_hi) KV_LOAD8(kbase + (size_t)(jb_lo + 1) * 64 * kstride, vbase + (jb_lo + 1) * 64)
  __syncthreads();
#pragma unroll 1
  for (int jb = jb_lo; jb <= jb_hi; ++jb) {
    const int cur = (jb - jb_lo) & 1;
    const bf16* sK = sK0 + cur * (128 * LDK);
    const bf16* sVt = sK + 64 * LDK;
    if (jb < jb_hi) {
      bf16* dK = sK0 + (cur ^ 1) * (128 * LDK);
      *(uint4*)(dK + lrow * LDK + lcc * 8) = rk0;
      *(uint4*)(dK + 64 * LDK + lrow * LDK + lcc * 8) = rv0;
    }
    if (jb + 1 < jb_hi) KV_LOAD8(kbase + (size_t)(jb + 2) * 64 * kstride, vbase + (jb + 2) * 64)
    const bool full = (jb >= full_lo) && (jb <= full_hi);
    f32x16 s0 = qk_tile(sK, LDK, qf, l31, hh);
    f32x16 s1 = qk_tile(sK + 32 * LDK, LDK, qf, l31, hh);
    bool selb = true;
    if (MODE == 2) selb = ((jb < 32 ? sel_lo >> jb : sel_hi >> (jb - 32)) & 1u) != 0;
    if (!full) {
#pragma unroll
      for (int i = 0; i < 16; ++i) {
        const int key = jb * 64 + crow(i, hh);
        bool v0, v1;
        if (MODE <= 1) { v0 = key <= nmax; v1 = key + 32 <= nmax; }
        else if (MODE == 2) { v0 = selb && key <= t; v1 = selb && key + 32 <= t; }
        else { v0 = key <= t && key > t - 512; v1 = key + 32 <= t && key + 32 > t - 512; }
        s0[i] = v0 ? s0[i] : -1e30f;
        s1[i] = v1 ? s1[i] : -1e30f;
      }
    }
    if (MODE == 1) {
#pragma unroll
      for (int i = 0; i < 16; ++i) {
        float a0 = s0[i], a1 = s1[i];
        float p0 = __builtin_amdgcn_exp2f(a0 - m) * inv_l, p1 = __builtin_amdgcn_exp2f(a1 - m) * inv_l;
        s0[i] = (full || a0 > -1e29f) ? p0 : 0.f;
        s1[i] = (full || a1 > -1e29f) ? p1 : 0.f;
      }
#pragma unroll
      for (int sub = 0; sub < 2; ++sub) {
        const f32x16& pp = sub ? s1 : s0;
        float e0 = xor32x(pp[3], hh), e1 = xor32x(pp[7], hh), e2 = xor32x(pp[11], hh), e3 = xor32x(pp[15], hh);
        float r0 = hh ? e0 : carry, r1 = hh ? e1 : e0, r2 = hh ? e2 : e1, r3 = hh ? e3 : e2;
        carry = e3;
        float* dst = imp_row + ((jb * 64 + sub * 32) >> 2) + hh;
        dst[0] = 2.f * (pp[0] + pp[1] + pp[2]) + pp[3] + r0;
        dst[2] = 2.f * (pp[4] + pp[5] + pp[6]) + pp[7] + r1;
        dst[4] = 2.f * (pp[8] + pp[9] + pp[10]) + pp[11] + r2;
        dst[6] = 2.f * (pp[12] + pp[13] + pp[14]) + pp[15] + r3;
      }
    } else {
      float mx = -1e30f;
#pragma unroll
      for (int i = 0; i < 16; ++i) mx = max3f(mx, s0[i], s1[i]);
      mx = rmax32(mx);
      if (MODE == 2 && full) mx = selb ? mx : -1e30f;
      if (__any(mx > m + 8.f)) {
        const float m_new = fmaxf(m, mx);
        const float alpha = __builtin_amdgcn_exp2f(m - m_new);
        l *= alpha; m = m_new;
        if (MODE >= 2) {
#pragma unroll
          for (int i = 0; i < 16; ++i) { o[0][i] *= alpha; o[1][i] *= alpha; }
        }
      }
      const float msub = (MODE == 2 && full && !selb) ? 1e30f : m;
      const fl2_t m2 = {msub, msub};
      fl2_t rs2 = {0.f, 0.f};
#pragma unroll
      for (int i = 0; i < 16; i += 2) {
        fl2_t a = {s0[i], s0[i + 1]}, c = {s1[i], s1[i + 1]};
        fl2_t da = a - m2, dc = c - m2;
        fl2_t pa = {__builtin_amdgcn_exp2f(da.x), __builtin_amdgcn_exp2f(da.y)};
        fl2_t pc = {__builtin_amdgcn_exp2f(dc.x), __builtin_amdgcn_exp2f(dc.y)};
        if (!full) {
          pa.x = a.x > -1e29f ? pa.x : 0.f; pa.y = a.y > -1e29f ? pa.y : 0.f;
          pc.x = c.x > -1e29f ? pc.x : 0.f; pc.y = c.y > -1e29f ? pc.y : 0.f;
        }
        s0[i] = pa.x; s0[i + 1] = pa.y; s1[i] = pc.x; s1[i + 1] = pc.y;
        rs2 += pa; rs2 += pc;
      }
      l += rsum32(rs2.x + rs2.y);
    }
    if (MODE >= 1) {
      pv_tile(o, sVt, LDK, pack_half(s0, 0), pack_half(s0, 1), l31, hh);
      pv_tile(o, sVt + 32, LDK, pack_half(s1, 0), pack_half(s1, 1), l31, hh);
    }
    __syncthreads();
  }
#undef KV_LOAD8
}

DI void nsa_unit(const Params& p, int u, char* lds) {
  int tid_ = threadIdx.x; asm volatile("" : "+v"(tid_));
  const int tid = tid_, lane = tid & 63, w = tid >> 6, l31 = lane & 31, hh = lane >> 5;
  const int hw = w & 3, qs = w >> 2;
  const int qt = (u < 256) ? 63 - (u >> 3) : ((u - 256) >> 3), bg = u & 7, b = bg >> 1, g = bg & 1;
  const int t0 = qt * 64, t = t0 + qs * 32 + l31, c64 = t0 >> 6;
  const size_t tok = (size_t)b * 4096 + t;
  bf16* sK = (bf16*)lds;
  bf16* sVt = sK + 64 * LDK;
  float* imp = (float*)(lds + 4 * 64 * LDK * 2);
  unsigned* selm = (unsigned*)(imp + 4 * 64 * 64);
  const int head = g * 4 + hw;
  QF qf;
  {
    const bf16* qp = p.proj + tok * kNP + C_NQ + head * 64 + hh * 8;
    qf.q0 = *(const bf16x8*)(qp); qf.q1 = *(const bf16x8*)(qp + 16); qf.q2 = *(const bf16x8*)(qp + 32); qf.q3 = *(const bf16x8*)(qp + 48);
  }
  float gc, gs, gw;
  {
    const bf16* gp = p.proj + tok * kNP + C_NGL + head * 3;
    gc = sigmoidf_(bf2f(gp[0])); gs = sigmoidf_(bf2f(gp[1])); gw = sigmoidf_(bf2f(gp[2]));
  }
  f32x16 o[2];
  float m, l;
  const int nmax = (t - 31) >> 4;
  const int ncmp_tiles = (t0 / 16 + 3 + 63) >> 6;
  const int cfull_hi = ((((t0 - 31) >> 4) - 63) >> 6);
  const bf16* kcb = p.kc + (size_t)(b * 2 + g) * 256 * 64;
  const bf16* vcb = p.vct + (size_t)(b * 2 + g) * 64 * 256;
  float* imp_row = imp + hw * 4096 + (qs * 32 + l31) * 64;
  m = -1e30f; l = 0.f;
  const int lrow = tid >> 3, lcc = tid & 7;
  uint4 c2k = *(const uint4*)(kcb + (size_t)lrow * 64 + lcc * 8), c2v = *(const uint4*)(vcb + (size_t)lrow * 256 + lcc * 8);
  nsa_branch<0>(kcb, 64, vcb, 256, 0, ncmp_tiles - 1, 0, cfull_hi, sK, sVt, qf, t, nmax, 0u, 0u, m, l, o, nullptr, tid, l31, hh, false, c2k, c2v);
  o[0] = zero16(); o[1] = zero16();
  nsa_branch<1>(kcb, 64, vcb, 256, 0, ncmp_tiles - 1, 0, cfull_hi, sK, sVt, qf, t, nmax, 0u, 0u, m, l, o, imp_row, tid, l31, hh, true, c2k, c2v);
  __syncthreads();
  const bf16* kb_s = p.proj + (size_t)b * 4096 * kNP + C_NKS + g * 64;
  const bf16* vb_s = p.vst + (size_t)(b * 2 + g) * 64 * 4096;
  const bf16* kb_w = p.proj + (size_t)b * 4096 * kNP + C_NKW + g * 64;
  const bf16* vb_w = p.vwt + (size_t)(b * 2 + g) * 64 * 4096;
  const int jlo_w = c64 - 8 < 0 ? 0 : c64 - 8;
  const uint4 sk0 = *(const uint4*)(kb_s + (size_t)lrow * kNP + lcc * 8), sv0 = *(const uint4*)(vb_s + (size_t)lrow * 4096 + lcc * 8);
  const uint4 wk0 = *(const uint4*)(kb_w + (size_t)(jlo_w * 64 + lrow) * kNP + lcc * 8), wv0 = *(const uint4*)(vb_w + (size_t)lrow * 4096 + jlo_w * 64 + lcc * 8);
#pragma unroll 1
  for (int qi = 0; qi < 8; ++qi) {
    const int q = w * 8 + qi, j = lane;
    float v = imp[(0 * 64 + q) * 64 + j] + imp[(1 * 64 + q) * 64 + j] + imp[(2 * 64 + q) * 64 + j] + imp[(3 * 64 + q) * 64 + j];
    const bool causal = j <= c64;
    const bool forced = (j == 0) | (j == c64) | (j == c64 - 1);
    v = forced ? 1.0e4f : (causal ? v : 0.f);
    const unsigned key = causal ? ((__float_as_uint(v) & ~63u) | (unsigned)(63 - j)) : 0u;
    int rank = 0;
#pragma unroll
    for (int i = 0; i < 64; ++i) {
      unsigned ki = __builtin_amdgcn_readlane(key, i);
      rank += (ki > key) ? 1 : 0;
    }
    const bool sel = (rank < 16) & causal;
    unsigned long long mk = __ballot(sel);
    if (lane == 0) { selm[q * 2] = (unsigned)mk; selm[q * 2 + 1] = (unsigned)(mk >> 32); }
  }
  __syncthreads();
  const unsigned sel_lo = selm[(qs * 32 + l31) * 2], sel_hi = selm[(qs * 32 + l31) * 2 + 1];
  float* rs_ = imp + w * 2048 + lane;
#pragma unroll
  for (int et = 0; et < 2; ++et)
#pragma unroll
    for (int i = 0; i < 16; ++i) rs_[(et * 16 + i) * 64] = gc * o[et][i];
  {
    m = -1e30f; l = 0.f; o[0] = zero16(); o[1] = zero16();
    const bf16* kb = p.proj + (size_t)b * 4096 * kNP + C_NKS + g * 64;
    const bf16* vb = p.vst + (size_t)(b * 2 + g) * 64 * 4096;
    nsa_branch<2>(kb, kNP, vb, 4096, 0, c64, 0, c64 - 1, sK, sVt, qf, t, 0, sel_lo, sel_hi, m, l, o, nullptr, tid, l31, hh, true, sk0, sv0);
    const float sc = gs / l;
#pragma unroll
    for (int et = 0; et < 2; ++et)
#pragma unroll
      for (int i = 0; i < 16; ++i) rs_[(et * 16 + i) * 64] += sc * o[et][i];
  }
  {
    m = -1e30f; l = 0.f; o[0] = zero16(); o[1] = zero16();
    const bf16* kb = p.proj + (size_t)b * 4096 * kNP + C_NKW + g * 64;
    const bf16* vb = p.vwt + (size_t)(b * 2 + g) * 64 * 4096;
    const int jlo = c64 - 8 < 0 ? 0 : c64 - 8;
    const int flo = c64 - 7 < 0 ? 0 : c64 - 7;
    nsa_branch<3>(kb, kNP, vb, 4096, jlo, c64, flo, c64 - 1, sK, sVt, qf, t, 0, 0u, 0u, m, l, o, nullptr, tid, l31, hh, true, wk0, wv0);
    const float sc = gw / l;
#pragma unroll
    for (int et = 0; et < 2; ++et)
#pragma unroll
      for (int i = 0; i < 16; ++i) o[et][i] = rs_[(et * 16 + i) * 64] + sc * o[et][i];
  }
  uint2 grv[2][4];
#pragma unroll
  for (int et = 0; et < 2; ++et)
#pragma unroll
    for (int g4 = 0; g4 < 4; ++g4)
      grv[et][g4] = *(const uint2*)(p.proj + tok * kNP + C_NG + head * 64 + et * 32 + 8 * g4 + 4 * hh);
#pragma unroll
  for (int et = 0; et < 2; ++et)
#pragma unroll
    for (int g4 = 0; g4 < 4; ++g4) {
      const int e = et * 32 + 8 * g4 + 4 * hh;
      uint2 gr = grv[et][g4];
      float g0 = __uint_as_float(gr.x << 16), g1 = __uint_as_float(gr.x & 0xffff0000u);
      float g2 = __uint_as_float(gr.y << 16), g3 = __uint_as_float(gr.y & 0xffff0000u);
      uint2 uo;
      uo.x = pack2(o[et][g4 * 4 + 0] * siluf_(g0), o[et][g4 * 4 + 1] * siluf_(g1));
      uo.y = pack2(o[et][g4 * 4 + 2] * siluf_(g2), o[et][g4 * 4 + 3] * siluf_(g3));
      *(uint2*)(p.xb + tok * 1024 + 256 + head * 64 + e) = uo;
    }
}

DI void ln_phase(const Params& p, int layer) {
  int tid_ = threadIdx.x; asm volatile("" : "+v"(tid_));
  const int lane = tid_ & 63, w = tid_ >> 6;
  float4 ggv[4], bbv[4];
#pragma unroll
  for (int i = 0; i < 4; ++i) {
    ggv[i] = *(const float4*)(p.ln_g + layer * 1024 + (i * 64 + lane) * 4);
    bbv[i] = *(const float4*)(p.ln_b + layer * 1024 + (i * 64 + lane) * 4);
  }
  const int nwaves = gridDim.x * 8;
  constexpr int R = 4;
  for (int row0 = blockIdx.x * 8 + w; row0 < kT; row0 += R * nwaves) {
    float4 v[R][4];
    float sm[R], q[R], mean[R];
#pragma unroll
    for (int r = 0; r < R; ++r) {
      int row = row0 + r * nwaves; if (row >= kT) row = row0;
      sm[r] = 0.f;
#pragma unroll
      for (int i = 0; i < 4; ++i) {
        v[r][i] = *(const float4*)(p.out + (size_t)row * 1024 + (i * 64 + lane) * 4);
        sm[r] += v[r][i].x + v[r][i].y + v[r][i].z + v[r][i].w;
      }
    }
#pragma unroll
    for (int off = 32; off >= 1; off >>= 1) {
#pragma unroll
      for (int r = 0; r < R; ++r) sm[r] += __shfl_xor(sm[r], off, 64);
    }
#pragma unroll
    for (int r = 0; r < R; ++r) {
      mean[r] = sm[r] * (1.f / 1024.f); q[r] = 0.f;
#pragma unroll
      for (int i = 0; i < 4; ++i) {
        float a = v[r][i].x - mean[r], b = v[r][i].y - mean[r], c = v[r][i].z - mean[r], d = v[r][i].w - mean[r];
        q[r] += a * a + b * b + c * c + d * d;
      }
    }
#pragma unroll
    for (int off = 32; off >= 1; off >>= 1) {
#pragma unroll
      for (int r = 0; r < R; ++r) q[r] += __shfl_xor(q[r], off, 64);
    }
#pragma unroll
    for (int r = 0; r < R; ++r) {
      const int row = row0 + r * nwaves;
      if (row < kT) {
        const float rstd = rsqrtf(q[r] * (1.f / 1024.f) + 1e-5f);
#pragma unroll
        for (int i = 0; i < 4; ++i) {
          int col = (i * 64 + lane) * 4;
          float4 gg = ggv[i], bb = bbv[i];
          float4 y;
          y.x = (v[r][i].x - mean[r]) * rstd * gg.x + bb.x; y.y = (v[r][i].y - mean[r]) * rstd * gg.y + bb.y;
          y.z = (v[r][i].z - mean[r]) * rstd * gg.z + bb.z; y.w = (v[r][i].w - mean[r]) * rstd * gg.w + bb.w;
          *(float4*)(p.out + (size_t)row * 1024 + col) = y;
          if (layer == 0) {
            uint2 ub; ub.x = pack2(y.x, y.y); ub.y = pack2(y.z, y.w);
            *(uint2*)(p.xb + (size_t)row * 1024 + col) = ub;
          }
        }
      }
    }
  }
}

namespace pg8 {
#define PG8_LAS __attribute__((address_space(3)))
typedef unsigned short bf16_t;
typedef short bf16x8 __attribute__((ext_vector_type(8)));
typedef float f32x4 __attribute__((ext_vector_type(4)));
typedef unsigned u32x4 __attribute__((ext_vector_type(4)));
constexpr int BM = 256, BK = 64, HALF = 128, HTB = HALF * BK * 2  , STAGE_BYTES = 8 * HTB, NXCD = 8, WGM = 8;

__host__ __device__ __forceinline__ int lds_byte(int r, int c) { const int st = (r >> 4) * 2 + (c >> 5), rr = r & 15, cc = c & 31, ob = rr * 64 + cc * 2; return st * 1024 + (ob ^ (((ob >> 9) & 1) << 5)); }
__host__ __device__ __forceinline__ void stage_rc(int b, int& R, int& C) { const int st = b / 1024, sb = b % 1024, swz = sb ^ (((sb >> 9) & 1) << 5); R = (st >> 1) * 16 + swz / 64; C = (st & 1) * 32 + (swz % 64) / 2; }
__host__ __device__ __forceinline__ int perm32(int rho) { const int n = rho >> 4, i = rho & 15; return 8 * (i >> 2) + 4 * n + (i & 3); }

struct Unit { int pm, pn; };
struct Gemm { const bf16_t* A; const bf16_t* Bt; int M, N, K; };

struct StaticOrder {
    int nM, nN, nwg, G, c;
    __host__ __device__ void init(int M, int N, int G_, int c_) { nM = M / BM; nN = N / BM; nwg = nM * nN; G = G_; c = c_; }
    __host__ __device__ bool next(int i, Unit& u) const {
        const long L = (long)i * G + c; if (L >= nwg) return false;
        int wgid = (int)L; { const int q = nwg / NXCD, r = nwg % NXCD, xcd = wgid % NXCD, off = wgid / NXCD; wgid = (xcd < r ? xcd * (q + 1) : r * (q + 1) + (xcd - r) * q) + off; }
        const int nig = WGM * nN, gid = wgid / nig, fm = gid * WGM, gsz = (nM - fm) < WGM ? (nM - fm) : WGM;
        u.pm = fm + ((wgid % nig) % gsz); u.pn = (wgid % nig) / gsz; return true;
    }
    __device__ __forceinline__ void a_ready(const Unit&) const {}
    __device__ __forceinline__ void done(const Unit&) const {}
};
template <class Epi, class Sched, bool STAMP = false>
__device__ __forceinline__ void gemm_phase(PG8_LAS unsigned char* lds, const Gemm g, const Sched& S, const Epi& E, unsigned long long* stamps) {
    int tid_ = threadIdx.x; asm volatile("" : "+v"(tid_));
    const int tid = tid_, wid = __builtin_amdgcn_readfirstlane(tid >> 6), lane = tid & 63, wr = wid >> 2, wc = wid & 3, fr = lane & 15, fq = lane >> 4;
    const int K = g.K, nt = K / BK;
    int ts_lo = 0, ts_hi = 0, nts = 0; const unsigned long long rt_entry = STAMP ? (unsigned long long)wall_clock64() : 0ull;
#define PG8_STAMP() do { if (STAMP && wid == 0 && nts < 64) { const unsigned long long _c = (unsigned long long)clock64(); \
        ts_lo = (lane == nts) ? (int)(unsigned)_c : ts_lo; ts_hi = (lane == nts) ? (int)(unsigned)(_c >> 32) : ts_hi; ++nts; } } while (0)
    PG8_STAMP();
    unsigned voffA[2], voffB[2];
#pragma unroll
    for (int i = 0; i < 2; ++i) { int R, C; stage_rc(tid * 16 + i * 8192, R, C); const int Rb = Epi::PERM ? ((R & ~31) + perm32(R & 31)) : R;
        voffA[i] = (unsigned)(R * K + C) * 2u; voffB[i] = (unsigned)(Rb * K + C) * 2u; }
    const size_t kstep = (size_t)(BK * 2);
    const size_t hstep = (size_t)HALF * K * 2;
    const size_t tstep = 2 * hstep;
    const unsigned ldsw = (unsigned)wid * 1024u;
    const int aoff = lds_byte(wr * 64 + fr, fq * 8), boff = lds_byte(wc * 32 + fr, fq * 8);
#define PG8_SA(b, h) (((b) * 2 + (h)) * HTB)
#define PG8_SB(b, h) ((4 + (b) * 2 + (h)) * HTB)
#define PG8_STAGE(bufoff, gbase, voff) do { _Pragma("unroll") for (int _i = 0; _i < 2; ++_i) \
        __builtin_amdgcn_global_load_lds((const unsigned*)((const char*)(gbase) + (voff)[_i]), (PG8_LAS unsigned*)(lds + (bufoff) + ldsw + _i * 8192), 16, 0, 0); } while (0)
#define PG8_LDA(dst, b, h) do { _Pragma("unroll") for (int m = 0; m < 4; ++m) _Pragma("unroll") for (int k = 0; k < 2; ++k) dst[m][k] = *(const PG8_LAS bf16x8*)(lds + PG8_SA(b, h) + aoff + m * 2048 + k * 1024); } while (0)
#define PG8_LDB(dst, b, h) do { _Pragma("unroll") for (int n = 0; n < 2; ++n) _Pragma("unroll") for (int k = 0; k < 2; ++k) dst[n][k] = *(const PG8_LAS bf16x8*)(lds + PG8_SB(b, h) + boff + n * 2048 + k * 1024); } while (0)
#define PG8_MMA(ai, bj, At, Bt) do { __builtin_amdgcn_s_setprio(1); _Pragma("unroll") for (int m = 0; m < 4; ++m) _Pragma("unroll") for (int n = 0; n < 2; ++n) _Pragma("unroll") for (int k = 0; k < 2; ++k) \
        acc[ai][bj][m][n] = __builtin_amdgcn_mfma_f32_16x16x32_bf16(Bt[n][k], At[m][k], acc[ai][bj][m][n], 0, 0, 0); __builtin_amdgcn_s_setprio(0); } while (0)
#define PG8_WAIT_V(n) asm volatile("s_waitcnt vmcnt(" #n ")" ::: "memory")
#define PG8_WAIT_L(n) asm volatile("s_waitcnt lgkmcnt(" #n ")" ::: "memory")
#define PG8_BAR __builtin_amdgcn_s_barrier()
#define PG8_SCHED __builtin_amdgcn_sched_barrier(0)
    Unit cur, nxt; int ui = 0;
    if (!S.next(0, cur)) return;
    f32x4 acc[2][2][4][2];
#pragma unroll
    for (int a = 0; a < 2; ++a)
#pragma unroll
        for (int b = 0; b < 2; ++b)
#pragma unroll
            for (int m = 0; m < 4; ++m)
#pragma unroll
                for (int n = 0; n < 2; ++n) acc[a][b][m][n] = (f32x4){0.f, 0.f, 0.f, 0.f};
    bf16x8 At[4][2], B0[2][2], B1[2][2];
    const char* cA = (const char*)g.A + (size_t)cur.pm * tstep; const char* cB = (const char*)g.Bt + (size_t)cur.pn * tstep;
    S.a_ready(cur);
    PG8_STAGE(PG8_SB(0, 0), cB, voffB); PG8_STAGE(PG8_SA(0, 0), cA, voffA); PG8_STAGE(PG8_SB(0, 1), cB + hstep, voffB); PG8_STAGE(PG8_SA(0, 1), cA + hstep, voffA);
    if (wr == 1) PG8_BAR;
    PG8_WAIT_V(4); PG8_BAR;
    PG8_STAGE(PG8_SB(1, 0), cB + kstep, voffB); PG8_STAGE(PG8_SA(1, 0), cA + kstep, voffA); PG8_STAGE(PG8_SB(1, 1), cB + hstep + kstep, voffB);
    PG8_WAIT_V(6); PG8_BAR;
    PG8_STAMP();
    for (;;) {
        const bool has_next = S.next(ui + 1, nxt);
        const char* nA = has_next ? (const char*)g.A + (size_t)nxt.pm * tstep : cA; const char* nB = has_next ? (const char*)g.Bt + (size_t)nxt.pn * tstep : cB;
        for (int t = 0; t < nt; t += 2) {
            const bool last = (t == nt - 2);
            const char* a1 = cA + (size_t)(t + 1) * kstep;
            const char* a2 = last ? nA : cA + (size_t)(t + 2) * kstep; const char* b2 = last ? nB : cB + (size_t)(t + 2) * kstep;
            const char* a3 = a2 + kstep; const char* b3 = b2 + kstep;
            if (last && has_next) S.a_ready(nxt);
            PG8_LDB(B0, 0, 0); PG8_SCHED; PG8_LDA(At, 0, 0); PG8_STAGE(PG8_SA(1, 1), a1 + hstep, voffA);
            PG8_WAIT_L(8); PG8_BAR; PG8_WAIT_L(0); PG8_MMA(0, 0, At, B0); PG8_BAR; PG8_SCHED;
            PG8_LDB(B1, 0, 1); PG8_STAGE(PG8_SB(0, 0), b2, voffB);
            PG8_BAR; PG8_WAIT_L(0); PG8_MMA(0, 1, At, B1); PG8_BAR;
            PG8_LDA(At, 0, 1); PG8_STAGE(PG8_SA(0, 0), a2, voffA);
            PG8_BAR; PG8_WAIT_L(0); PG8_MMA(1, 0, At, B0); PG8_BAR; PG8_SCHED;
            PG8_STAGE(PG8_SB(0, 1), b2 + hstep, voffB);
            PG8_WAIT_V(6); PG8_BAR; PG8_MMA(1, 1, At, B1); PG8_BAR;
            PG8_LDB(B0, 1, 0); PG8_SCHED; PG8_LDA(At, 1, 0); PG8_STAGE(PG8_SA(0, 1), a2 + hstep, voffA);
            PG8_WAIT_L(8); PG8_BAR; PG8_WAIT_L(0); PG8_MMA(0, 0, At, B0); PG8_BAR; PG8_SCHED;
            PG8_LDB(B1, 1, 1); PG8_STAGE(PG8_SB(1, 0), b3, voffB);
            PG8_BAR; PG8_WAIT_L(0); PG8_MMA(0, 1, At, B1); PG8_BAR;
            PG8_LDA(At, 1, 1); PG8_STAGE(PG8_SA(1, 0), a3, voffA);
            PG8_BAR; PG8_WAIT_L(0); PG8_MMA(1, 0, At, B0); PG8_BAR; PG8_SCHED;
            PG8_STAGE(PG8_SB(1, 1), b3 + hstep, voffB);
            PG8_WAIT_V(6); PG8_BAR; PG8_MMA(1, 1, At, B1); PG8_BAR;
        }
        PG8_STAMP();
        if constexpr (!Epi::AFTER_DRAIN) { E(acc, cur, wr, wc, fr, fq); S.done(cur); }
        PG8_STAMP();
        if (!has_next) break;
#pragma unroll
        for (int a = 0; a < 2; ++a)
#pragma unroll
            for (int b = 0; b < 2; ++b)
#pragma unroll
                for (int m = 0; m < 4; ++m)
#pragma unroll
                    for (int n = 0; n < 2; ++n) acc[a][b][m][n] = (f32x4){0.f, 0.f, 0.f, 0.f};
        cur = nxt; cA = nA; cB = nB; ++ui;
    }
    PG8_WAIT_V(0);
    if (wr == 0) PG8_BAR;
    PG8_BAR;
    if constexpr (Epi::AFTER_DRAIN) { E.fused(acc, cur, wr, wc, fr, fq, lds, wid, lane); S.done(cur); }
    PG8_STAMP();
    if (STAMP && wid == 0) { stamps[lane] = lane < nts ? (((unsigned long long)(unsigned)ts_hi << 32) | (unsigned)ts_lo) : 0ull;
        if (lane == 62) stamps[62] = rt_entry; if (lane == 63) stamps[63] = (unsigned long long)wall_clock64(); }
#undef PG8_STAMP
#undef PG8_SA
#undef PG8_SB
#undef PG8_STAGE
#undef PG8_LDA
#undef PG8_LDB
#undef PG8_MMA
#undef PG8_WAIT_V
#undef PG8_WAIT_L
#undef PG8_BAR
#undef PG8_SCHED
}
}


struct EpiIn {
  static constexpr bool PERM = false, AFTER_DRAIN = false;
  bf16 *proj, *kdt, *vrt, *vst, *vwt; const float* rot;
  __device__ __forceinline__ void operator()(const pg8::f32x4 (&acc)[2][2][4][2], const pg8::Unit& u, int wr, int wc, int fr, int fq) const {
    const int a = wc & 1, f = 16 * a + 4 * fq;
#pragma unroll
    for (int bj = 0; bj < 2; ++bj) {
      const int seg = u.pn * 4 + bj * 2 + (wc >> 1);
      if (seg >= 54) continue;
      const bool is_rot = seg < 8;
      const float scale = (seg >= 4 && seg < 8) ? 0.125f : ((seg >= 16 && seg < 24) ? 0.125f * 1.4426950408889634f : 1.f);
      bf16* tdst = nullptr; int hd = 0, nh = 1; float lg2g = 0.f;
      if (seg >= 4 && seg < 8) { tdst = kdt; hd = seg - 4; nh = 4; lg2g = log2f(1.f - exp2f(-5.f - (float)hd)); }
      else if (seg >= 8 && seg < 12) { tdst = vrt; hd = seg - 8; nh = 4; }
      else if (seg == 30 || seg == 31) { tdst = vst; hd = seg - 30; nh = 2; }
      else if (seg == 34 || seg == 35) { tdst = vwt; hd = seg - 34; nh = 2; }
      const bool natural = !((seg >= 8 && seg < 12) || seg == 30 || seg == 31 || seg == 34 || seg == 35);
#pragma unroll
      for (int ai = 0; ai < 2; ++ai)
#pragma unroll
        for (int m = 0; m < 4; ++m) {
          const int row = u.pm * 256 + ai * 128 + wr * 64 + m * 16 + fr;
          const int bb = row >> 12, sq = row & 4095;
          pg8::f32x4 v0 = acc[ai][bj][m][0], v1 = acc[ai][bj][m][1];
          if (is_rot) {
            const float4* rp = (const float4*)(rot + ((size_t)sq * 32 + f) * 2);
            float4 c01 = rp[0], c23 = rp[1];
            float cs[4] = {c01.x, c01.z, c23.x, c23.z}, sn[4] = {c01.y, c01.w, c23.y, c23.w};
#pragma unroll
            for (int j = 0; j < 4; ++j) { float x0 = v0[j], x1 = v1[j]; v0[j] = x0 * cs[j] - x1 * sn[j]; v1[j] = x0 * sn[j] + x1 * cs[j]; }
          }
          if (scale != 1.f) { v0 *= scale; v1 *= scale; }
          if (natural) {
            uint2 q0; q0.x = pack2(v0[0], v0[1]); q0.y = pack2(v0[2], v0[3]);
            uint2 q1; q1.x = pack2(v1[0], v1[1]); q1.y = pack2(v1[2], v1[3]);
            bf16* dst = proj + (size_t)row * kNP + seg * 64 + f;
            *(uint2*)(dst) = q0; *(uint2*)(dst + 32) = q1;
          }
          if (tdst) {
            const float kd = (lg2g != 0.f) ? exp2f((float)(127 - (sq & 127)) * lg2g) : 1.f;
            bf16* tb = tdst + ((size_t)(bb * nh + hd) * 64 + f) * 4096 + sq;
#pragma unroll
            for (int j = 0; j < 4; ++j) { tb[(size_t)j * 4096] = f2bf(v0[j] * kd); tb[(size_t)(32 + j) * 4096] = f2bf(v1[j] * kd); }
          }
        }
    }
  }
};
struct EpiOut {
  static constexpr bool PERM = false, AFTER_DRAIN = false;
  const float* res; float* out;
  __device__ __forceinline__ void operator()(const pg8::f32x4 (&acc)[2][2][4][2], const pg8::Unit& u, int wr, int wc, int fr, int fq) const {
    const float alpha = 1.41421356237f;
    const int row0 = u.pm * 256 + wr * 64 + fr, col0 = u.pn * 256 + wc * 32 + 4 * fq;
#pragma unroll
    for (int ai = 0; ai < 2; ++ai)
#pragma unroll
      for (int m = 0; m < 4; ++m) {
        const size_t off = (size_t)(row0 + ai * 128 + m * 16) * 1024 + col0;
        pg8::f32x4 rv[2][2];
#pragma unroll
        for (int bj = 0; bj < 2; ++bj)
#pragma unroll
          for (int n = 0; n < 2; ++n) rv[bj][n] = *(const pg8::f32x4*)(res + off + bj * 128 + n * 16);
#pragma unroll
        for (int bj = 0; bj < 2; ++bj)
#pragma unroll
          for (int n = 0; n < 2; ++n) *(pg8::f32x4*)(out + off + bj * 128 + n * 16) = alpha * rv[bj][n] + acc[ai][bj][m][n];
      }
  }
};

DI unsigned bar_ld(unsigned* q) { return __hip_atomic_load(q, __ATOMIC_RELAXED, __HIP_MEMORY_SCOPE_AGENT); }
DI unsigned bar_add(unsigned* q, unsigned v) { return __hip_atomic_fetch_add(q, v, __ATOMIC_RELAXED, __HIP_MEMORY_SCOPE_AGENT); }
DI unsigned xcc_id() { return (unsigned)__builtin_amdgcn_s_getreg((3 << 11) | 20) & 0xFu; }

DI void grid_barrier(unsigned* ctr, unsigned target) {
  asm volatile("s_waitcnt vmcnt(0)" ::: "memory");
  __syncthreads();
  if (threadIdx.x == 0) {
    __builtin_amdgcn_fence(__ATOMIC_RELEASE, "agent");
    asm volatile("s_waitcnt vmcnt(0)" ::: "memory");
    bar_add(ctr, 1u);
    while (bar_ld(ctr) < target) __builtin_amdgcn_s_sleep(1);
    __builtin_amdgcn_fence(__ATOMIC_ACQUIRE, "agent");
    asm volatile("s_waitcnt vmcnt(0)" ::: "memory");
  }
  __syncthreads();
}

DI void xcd_barrier(unsigned* bar, unsigned xcc, unsigned nloc, unsigned nx, unsigned k) {
  asm volatile("s_waitcnt vmcnt(0)" ::: "memory");
  __syncthreads();
  if (threadIdx.x == 0) {
    const unsigned old = bar_add(&bar[1024 + 64 * xcc], 1u);
    if (old + 1u == k * nloc) {
      __builtin_amdgcn_fence(__ATOMIC_RELEASE, "agent");
      asm volatile("s_waitcnt vmcnt(0)" ::: "memory");
      const unsigned og = bar_add(&bar[3072], 1u);
      if (og + 1u == k * nx) bar_add(&bar[3136], 1u);
      else while (bar_ld(&bar[3136]) < k) __builtin_amdgcn_s_sleep(1);
      __builtin_amdgcn_fence(__ATOMIC_ACQUIRE, "agent");
      bar_add(&bar[2048 + 64 * xcc], 1u);
      asm volatile("s_waitcnt vmcnt(0)" ::: "memory");
    } else {
      while (bar_ld(&bar[2048 + 64 * xcc]) < k) __builtin_amdgcn_s_sleep(1);
      __builtin_amdgcn_fence(__ATOMIC_ACQUIRE, "agent");
      asm volatile("s_waitcnt vmcnt(0)" ::: "memory");
    }
  }
  __syncthreads();
}

__global__ void __launch_bounds__(512) mega(Params p) {
  extern __shared__ __attribute__((aligned(16))) char lds[];
  unsigned* bst = (unsigned*)(lds + LDS_BYTES);
  cg::grid_group grid = cg::this_grid();
  const int G = gridDim.x, bid = blockIdx.x;
  if (p.bar == nullptr) grid.sync();
  const unsigned xcc = xcc_id();
  if (threadIdx.x == 0) bar_add(&p.bar[64 * xcc], 1u);
  phase_prologue<1>(p, bid, G);
  grid_barrier(&p.bar[3200], (unsigned)G);
  if (threadIdx.x == 0) {
    unsigned mine = 0, cnt = 0;
    for (unsigned j = 0; j < 16; ++j) { const unsigned c = bar_ld(&p.bar[64 * j]); cnt += c > 0u ? 1u : 0u; mine = (j == xcc) ? c : mine; }
    bst[0] = mine; bst[1] = cnt;
  }
  __syncthreads();
  const unsigned nloc = bst[0], nx = bst[1];
  unsigned nbar = 0;
  const int GW = G; const int wb = bid;
#define GRID_BARRIER() { ++nbar; xcd_barrier(p.bar, xcc, nloc, nx, nbar); }
#pragma unroll 1
  for (int layer = 0; layer < 2; ++layer) {
    __syncthreads();
    {
      pg8::Gemm gg; gg.A = p.xb; gg.Bt = p.wint + (size_t)layer * kNW * 1024; gg.M = kT; gg.N = kNW; gg.K = 1024;
      pg8::StaticOrder so; so.init(kT, kNW, G, bid);
      EpiIn ei; ei.proj = p.proj; ei.kdt = p.kdt; ei.vrt = p.vrt; ei.vst = p.vst; ei.vwt = p.vwt; ei.rot = p.rot;
      pg8::gemm_phase<EpiIn, pg8::StaticOrder, false>((PG8_LAS unsigned char*)lds, gg, so, ei, nullptr);
    }
    if (layer == 0) { if (G == 256) { if (bid >= 128) phase_prologue<2>(p, bid - 128, 128); } else phase_prologue<2>(p, bid, G); }
    GRID_BARRIER()
#pragma unroll 1
    for (int u = (G == 256 ? (bid + 128) & 255 : wb); u < 128; u += GW) nsa_cmp_unit(p, layer, u, lds);
#pragma unroll 1
    for (int u = wb; u < 256; u += GW) lru_local_unit(p, layer, u, lds);
#pragma unroll 1
    for (int u = wb; u < 256; u += GW) ret_kv_unit(p, u);
    GRID_BARRIER()
#pragma unroll 1
    for (int u = wb; u < 512; u += GW) nsa_unit(p, u, lds);
#pragma unroll 1
    for (int u = wb; u < 256; u += GW) ret_out_unit(p, u, lds);
#pragma unroll 1
    for (int u = wb; u < 256; u += GW) lru_out_unit(p, u);
    GRID_BARRIER()
    __syncthreads();
    {
      pg8::Gemm gg; gg.A = p.xb; gg.Bt = p.woutt + (size_t)layer * 1024 * 1024; gg.M = kT; gg.N = 1024; gg.K = 1024;
      pg8::StaticOrder so; so.init(kT, 1024, G, bid);
      EpiOut eo; eo.res = layer == 0 ? p.x : p.out; eo.out = p.out;
      pg8::gemm_phase<EpiOut, pg8::StaticOrder, false>((PG8_LAS unsigned char*)lds, gg, so, eo, nullptr);
    }
    GRID_BARRIER()
    ln_phase(p, layer);
    if (layer == 0) GRID_BARRIER()
  }
#undef GRID_BARRIER
}

extern "C" void kernel_launch(void* const* d_in, const int* in_sizes, int n_in, void* d_out, int out_size, void* d_ws,
                              size_t ws_size, hipStream_t stream) {
  static int grid_blocks = 0;
  if (!grid_blocks) {
    int dev = 0, cus = 0, per_cu = 0;
    (void)hipGetDevice(&dev);
    (void)hipDeviceGetAttribute(&cus, hipDeviceAttributeMultiprocessorCount, dev);
    (void)hipFuncSetAttribute((const void*)mega, hipFuncAttributeMaxDynamicSharedMemorySize, LDS_BYTES + 16);
    (void)hipOccupancyMaxActiveBlocksPerMultiprocessor(&per_cu, mega, 512, LDS_BYTES + 16);
    if (per_cu > 1) per_cu = 1;
    if (per_cu < 1) per_cu = 1;
    grid_blocks = cus * per_cu;
  }
  Params p{};
  p.x = (const float*)d_in[0]; p.w_in = (const float*)d_in[1]; p.w_out = (const float*)d_in[2];
  p.ln_g = (const float*)d_in[3]; p.ln_b = (const float*)d_in[4]; p.cmp_pos = (const float*)d_in[5];
  p.cmp_w = (const float*)d_in[6]; p.conv_w = (const float*)d_in[7]; p.conv_b = (const float*)d_in[8];
  p.w_a = (const float*)d_in[9]; p.b_a = (const float*)d_in[10]; p.w_x = (const float*)d_in[11];
  p.b_x = (const float*)d_in[12]; p.lam = (const float*)d_in[13];
  p.out = (float*)d_out;
  char* ws = (char*)d_ws;
  size_t off = 0;
  auto take = [&](size_t bytes) { char* r = ws + off; off += (bytes + 255) & ~(size_t)255; return r; };
  p.xb = (bf16*)take((size_t)kT * 1024 * 2);
  p.wint = (bf16*)take((size_t)2 * kNW * 1024 * 2);
  p.woutt = (bf16*)take((size_t)2 * 1024 * 1024 * 2);
  p.cmpwt = (bf16*)take((size_t)4 * 64 * 2048 * 2);
  p.proj = (bf16*)take((size_t)kT * kNP * 2);
  p.kdt = (bf16*)take((size_t)16 * 64 * 4096 * 2);
  p.vrt = (bf16*)take((size_t)16 * 64 * 4096 * 2);
  p.vst = (bf16*)take((size_t)8 * 64 * 4096 * 2);
  p.vwt = (bf16*)take((size_t)8 * 64 * 4096 * 2);
  p.kc = (bf16*)take((size_t)8 * 256 * 64 * 2);
  p.vct = (bf16*)take((size_t)8 * 64 * 256 * 2);
  p.wat = (bf16*)take((size_t)8 * 64 * 64 * 2);
  p.wxt = (bf16*)take((size_t)8 * 64 * 64 * 2);
  p.cmpbp = (float*)take((size_t)64 * 32 * 4);
  p.rot = (float*)take((size_t)4096 * 32 * 2 * 4);
  p.kvc = (float*)take((size_t)512 * 4096 * 4);
  p.cuma = (float*)take((size_t)kT * 256 * 4);
  p.hloc = (float*)take((size_t)kT * 256 * 4);
  p.suma = (float*)take((size_t)4 * 128 * 256 * 4);
  p.sumh = (float*)take((size_t)4 * 128 * 256 * 4);
  p.bar = (unsigned*)take(16384);
  if (off > ws_size) { fprintf(stderr, "workspace too small: need %zu have %zu\n", off, ws_size); return; }
  (void)hipMemsetAsync(p.bar, 0, 16384, stream);
  void* args[] = {&p};
  hipError_t e = hipLaunchCooperativeKernel((void*)mega, dim3(grid_blocks), dim3(512), args, LDS_BYTES + 16, stream);
  if (e != hipSuccess) fprintf(stderr, "cooperative launch failed: %s (grid %d)\n", hipGetErrorString(e), grid_blocks);
}
```
